# Optimizing an MI355X kernel written in HIP

```python
import jax
import jax.numpy as jnp
from jax import lax
import numpy as np

D_MODEL = 1024
BATCH = 1
SEQ = 16384
DEPTH = 2

GRID_W = 64
CTX_LEN = 256
HEAD_DIM = 64
N_Q_HEADS = 12
N_KV_HEADS = 4
Q_PER_KV = N_Q_HEADS // N_KV_HEADS
ATTN_WIDTH = N_Q_HEADS * HEAD_DIM
KV_WIDTH = N_KV_HEADS * HEAD_DIM
N_FOURIER_GROUPS = 4
FOURIER_GROUP_DIM = 64
FOURIER_WIDTH = N_FOURIER_GROUPS * FOURIER_GROUP_DIM
MIX_WIDTH = ATTN_WIDTH + FOURIER_WIDTH
EVEN_IN_WIDTH = ATTN_WIDTH + 2 * KV_WIDTH + FOURIER_WIDTH
EVEN_SPLITS = (ATTN_WIDTH, ATTN_WIDTH + KV_WIDTH, ATTN_WIDTH + 2 * KV_WIDTH)
CONV_WIDTH = D_MODEL
CONV_K = 3
D_FF = 2816
N_EXPERTS = 8
TOP_K = 2
D_EXPERT = 3584
Q_BLOCK = 128
ROPE_THETA = 10000.0
ROPE_AXIS_DIM = HEAD_DIM // 2
NORM_EPS = 1e-6
N_EVEN = (DEPTH + 1) // 2
N_ODD = DEPTH // 2

kernel_name = 'hybrid_fourier_gqa_shortconv_moe_dit'


def rmsnorm(x, g):
    xf = x.astype(jnp.float32)
    y = xf * lax.rsqrt(jnp.mean(xf * xf, axis=-1, keepdims=True) + NORM_EPS)
    return (y * g.astype(jnp.float32)).astype(x.dtype)


def modulate(x, g, shift, scale):
    return rmsnorm(x, g) * (1 + scale) + shift


def axial_rope_angles(n_tokens):
    rows = n_tokens // GRID_W
    row = jnp.repeat(jnp.arange(rows, dtype=jnp.float32), GRID_W)
    col = jnp.tile(jnp.arange(GRID_W, dtype=jnp.float32), rows)
    half = ROPE_AXIS_DIM // 2
    inv_freq = ROPE_THETA ** (-jnp.arange(half, dtype=jnp.float32) / half)
    return row[:, None] * inv_freq, col[:, None] * inv_freq


def rotate_axis(x, ang):
    cos = jnp.cos(ang)[None, :, None, :]
    sin = jnp.sin(ang)[None, :, None, :]
    x1, x2 = jnp.split(x, 2, axis=-1)
    return jnp.concatenate([x1 * cos - x2 * sin, x1 * sin + x2 * cos], axis=-1)


def rope_2d(x, ang_row, ang_col):
    xf = x.astype(jnp.float32)
    out = jnp.concatenate([rotate_axis(xf[..., :ROPE_AXIS_DIM], ang_row),
                           rotate_axis(xf[..., ROPE_AXIS_DIM:], ang_col)], axis=-1)
    return out.astype(x.dtype)


def heads(t, n):
    return t.reshape(t.shape[0], t.shape[1], n, HEAD_DIM)


def gqa_attend(q, k, v):
    b, lq = q.shape[0], q.shape[1]
    n_blk = lq // Q_BLOCK
    kf = k.astype(jnp.float32)
    qb = q.reshape(b, n_blk, Q_BLOCK, N_KV_HEADS, Q_PER_KV, HEAD_DIM).transpose(1, 0, 2, 3, 4, 5)
    scale = HEAD_DIM ** -0.5

    def one_block(q_blk):
        s = jnp.einsum('bqkgd,bskd->bkgqs', q_blk.astype(jnp.float32), kf) * scale
        p = jax.nn.softmax(s, axis=-1).astype(v.dtype)
        return jnp.einsum('bkgqs,bskd->bqkgd', p, v)

    o = lax.map(one_block, qb)
    return o.transpose(1, 0, 2, 3, 4, 5).reshape(b, lq, ATTN_WIDTH)


def fourier_mix(u):
    b, l = u.shape[0], u.shape[1]
    ug = u.reshape(b, l, N_FOURIER_GROUPS, FOURIER_GROUP_DIM).astype(jnp.float32)
    z = jnp.fft.fft2(ug, axes=(1, 3), norm='ortho')
    return jnp.real(z).reshape(b, l, FOURIER_WIDTH).astype(u.dtype)


def parallel_fourier_gqa(h_lat, h_ctx, w_in, q_gain, k_gain, w_out, ang_row, ang_col, ctx_out):
    q, k, v, f = jnp.split(h_lat @ w_in, EVEN_SPLITS, axis=-1)
    q = rope_2d(rmsnorm(heads(q, N_Q_HEADS), q_gain), ang_row, ang_col)
    k = rope_2d(rmsnorm(heads(k, N_KV_HEADS), k_gain), ang_row, ang_col)
    v = heads(v, N_KV_HEADS)
    if ctx_out:
        q_c, k_c, v_c, f_c = jnp.split(h_ctx @ w_in, EVEN_SPLITS, axis=-1)
        q_c = rmsnorm(heads(q_c, N_Q_HEADS), q_gain)
    else:
        k_c, v_c = jnp.split(h_ctx @ w_in[:, ATTN_WIDTH:ATTN_WIDTH + 2 * KV_WIDTH], 2, axis=-1)
    k_c = rmsnorm(heads(k_c, N_KV_HEADS), k_gain)
    v_c = heads(v_c, N_KV_HEADS)
    attn = gqa_attend(q, jnp.concatenate([k, k_c], axis=1), jnp.concatenate([v, v_c], axis=1))
    y_lat = jnp.concatenate([attn, fourier_mix(f)], axis=-1) @ w_out
    y_ctx = None
    if ctx_out:
        attn_c = gqa_attend(q_c, k_c, v_c)
        y_ctx = jnp.concatenate([attn_c, fourier_mix(f_c)], axis=-1) @ w_out
    return y_lat, y_ctx


def short_conv3(u, w):
    up = jnp.pad(u, ((0, 0), (1, 1), (0, 0)))
    return up[:, :-2] * w[0] + up[:, 1:-1] * w[1] + up[:, 2:] * w[2]


def gated_short_conv(h, w_in, conv_w, w_out):
    b_gate, c_gate, u = jnp.split(h @ w_in, 3, axis=-1)
    return (b_gate * short_conv3(c_gate * u, conv_w)) @ w_out


def swiglu(h, w_gate, w_up, w_down):
    return (jax.nn.silu(h @ w_gate) * (h @ w_up)) @ w_down


def moe_swiglu(h, router, w_gate, w_up, w_down):
    logits = (h @ router).astype(jnp.float32)
    probs = jax.nn.softmax(logits, axis=-1)
    vals, idx = lax.top_k(probs, TOP_K)
    wts = vals / jnp.sum(vals, axis=-1, keepdims=True)
    combine = jnp.sum(jax.nn.one_hot(idx, N_EXPERTS, dtype=jnp.float32) * wts[..., None], axis=-2)
    combine = combine.astype(h.dtype)
    out = jnp.zeros_like(h)
    for e in range(N_EXPERTS):
        out = out + combine[..., e:e + 1] * swiglu(h, w_gate[e], w_up[e], w_down[e])
    return out


def _normal(key, shape, fan_in):
    return jax.random.normal(key, shape, jnp.float32) * (fan_in ** -0.5)


def setup_inputs(seed: int = 0) -> dict:
    key = jax.random.key(seed)
    ks = jax.random.split(key, 21)
    D = D_MODEL
    f32 = jnp.float32
    return {
        'x': jax.random.normal(ks[0], (BATCH, SEQ, D), f32),
        'c': jax.random.normal(ks[1], (BATCH, D), f32),
        'ctx': jax.random.normal(ks[2], (BATCH, CTX_LEN, D), f32),
        'c_ctx': jax.random.normal(ks[3], (D,), f32),
        'ada_w': _normal(ks[4], (DEPTH, D, 6 * D), D),
        'ada_b': 0.02 * jax.random.normal(ks[5], (DEPTH, 6 * D), f32),
        'norm_w': 1.0 + 0.05 * jax.random.normal(ks[6], (DEPTH, 4, D), f32),
        'e_w_in': _normal(ks[7], (N_EVEN, D, EVEN_IN_WIDTH), D),
        'e_q_gain': 1.0 + 0.05 * jax.random.normal(ks[8], (N_EVEN, HEAD_DIM), f32),
        'e_k_gain': 1.0 + 0.05 * jax.random.normal(ks[9], (N_EVEN, HEAD_DIM), f32),
        'e_w_out': _normal(ks[10], (N_EVEN, MIX_WIDTH, D), MIX_WIDTH),
        'e_ffn_gate': _normal(ks[11], (N_EVEN, D, D_FF), D),
        'e_ffn_up': _normal(ks[12], (N_EVEN, D, D_FF), D),
        'e_ffn_down': _normal(ks[13], (N_EVEN, D_FF, D), D_FF),
        'o_w_in': _normal(ks[14], (N_ODD, D, 3 * CONV_WIDTH), D),
        'o_conv_w': _normal(ks[15], (N_ODD, CONV_K, CONV_WIDTH), CONV_K),
        'o_w_out': _normal(ks[16], (N_ODD, CONV_WIDTH, D), CONV_WIDTH),
        'o_router': _normal(ks[17], (N_ODD, D, N_EXPERTS), D),
        'o_exp_gate': _normal(ks[18], (N_ODD, N_EXPERTS, D, D_EXPERT), D),
        'o_exp_up': _normal(ks[19], (N_ODD, N_EXPERTS, D, D_EXPERT), D),
        'o_exp_down': _normal(ks[20], (N_ODD, N_EXPERTS, D_EXPERT, D), D_EXPERT),
    }


def reference(x, c, ctx, c_ctx, ada_w, ada_b, norm_w, e_w_in, e_q_gain, e_k_gain, e_w_out,
              e_ffn_gate, e_ffn_up, e_ffn_down, o_w_in, o_conv_w, o_w_out, o_router,
              o_exp_gate, o_exp_up, o_exp_down):
    ang_row, ang_col = axial_rope_angles(x.shape[1])
    s_c = jax.nn.silu(c)
    s_ctx = jax.nn.silu(c_ctx)
    for i in range(DEPTH):
        even = (i % 2 == 0)
        ctx_out = any(j % 2 == 0 for j in range(i + 1, DEPTH))
        ctx_in = even or ctx_out
        g_pre_mix, g_post_mix, g_pre_ch, g_post_ch = norm_w[i, 0], norm_w[i, 1], norm_w[i, 2], norm_w[i, 3]
        sh1, sc1, gt1, sh2, sc2, gt2 = jnp.split((s_c @ ada_w[i] + ada_b[i])[:, None, :], 6, axis=-1)
        h_lat = modulate(x, g_pre_mix, sh1, sc1)
        h_ctx = None
        if ctx_in:
            csh1, csc1, cgt1, csh2, csc2, cgt2 = jnp.split(s_ctx @ ada_w[i] + ada_b[i], 6, axis=-1)
            h_ctx = modulate(ctx, g_pre_mix, csh1, csc1)
        if even:
            e = i // 2
            y_lat, y_ctx = parallel_fourier_gqa(h_lat, h_ctx, e_w_in[e], e_q_gain[e], e_k_gain[e],
                                                e_w_out[e], ang_row, ang_col, ctx_out)
        else:
            o = i // 2
            y_lat = gated_short_conv(h_lat, o_w_in[o], o_conv_w[o], o_w_out[o])
            y_ctx = gated_short_conv(h_ctx, o_w_in[o], o_conv_w[o], o_w_out[o]) if ctx_out else None
        x = x + gt1 * rmsnorm(y_lat, g_post_mix)
        if ctx_out:
            ctx = ctx + cgt1 * rmsnorm(y_ctx, g_post_mix)
        h_lat = modulate(x, g_pre_ch, sh2, sc2)
        if even:
            y_lat = swiglu(h_lat, e_ffn_gate[e], e_ffn_up[e], e_ffn_down[e])
        else:
            y_lat = moe_swiglu(h_lat, o_router[o], o_exp_gate[o], o_exp_up[o], o_exp_down[o])
        x = x + gt2 * rmsnorm(y_lat, g_post_ch)
        if ctx_out:
            h_ctx = modulate(ctx, g_pre_ch, csh2, csc2)
            if even:
                y_ctx = swiglu(h_ctx, e_ffn_gate[e], e_ffn_up[e], e_ffn_down[e])
            else:
                y_ctx = moe_swiglu(h_ctx, o_router[o], o_exp_gate[o], o_exp_up[o], o_exp_down[o])
            ctx = ctx + cgt2 * rmsnorm(y_ctx, g_post_ch)
    return x
```

```cpp
#include <hip/hip_runtime.h>
#include <cstdio>
#include <cstdint>
namespace pg8 {
#define PG8_LAS __attribute__((address_space(3)))
typedef unsigned short bf16_t;
typedef short bf16x8 __attribute__((ext_vector_type(8)));
typedef float f32x4 __attribute__((ext_vector_type(4)));
typedef unsigned u32x4 __attribute__((ext_vector_type(4)));
constexpr int BM = 256, BK = 64, HALF = 128, HTB = HALF * BK * 2  , STAGE_BYTES = 8 * HTB, NXCD = 8, WGM = 8;

__host__ __device__ __forceinline__ int lds_byte(int r, int c) { const int st = (r >> 4) * 2 + (c >> 5), rr = r & 15, cc = c & 31, ob = rr * 64 + cc * 2; return st * 1024 + (ob ^ (((ob >> 9) & 1) << 5)); }
__host__ __device__ __forceinline__ void stage_rc(int b, int& R, int& C) { const int st = b / 1024, sb = b % 1024, swz = sb ^ (((sb >> 9) & 1) << 5); R = (st >> 1) * 16 + swz / 64; C = (st & 1) * 32 + (swz % 64) / 2; }
__host__ __device__ __forceinline__ int perm32(int rho) { const int n = rho >> 4, i = rho & 15; return 8 * (i >> 2) + 4 * n + (i & 3); }

struct Unit { int pm, pn, pa, pb; };
struct Gemm { const bf16_t* A; const bf16_t* Bt; int M, N, K; };

struct StaticOrder {
    int nM, nN, nwg, G, c;
    __host__ __device__ void init(int M, int N, int G_, int c_) { nM = M / BM; nN = N / BM; nwg = nM * nN; G = G_; c = c_; }
    __host__ __device__ bool next(int i, Unit& u) const {
        const long L = (long)i * G + c; if (L >= nwg) return false;
        int wgid = (int)L; { const int q = nwg / NXCD, r = nwg % NXCD, xcd = wgid % NXCD, off = wgid / NXCD; wgid = (xcd < r ? xcd * (q + 1) : r * (q + 1) + (xcd - r) * q) + off; }
        const int nig = WGM * nN, gid = wgid / nig, fm = gid * WGM, gsz = (nM - fm) < WGM ? (nM - fm) : WGM;
        u.pm = fm + ((wgid % nig) % gsz); u.pn = (wgid % nig) / gsz; u.pa = u.pm; u.pb = u.pn; return true;
    }
    __device__ __forceinline__ void a_ready(const Unit&) const {}
    __device__ __forceinline__ void done(const Unit&) const {}
};

__device__ __forceinline__ unsigned cvt_pk_bf16(float lo, float hi) { unsigned r; asm volatile("v_cvt_pk_bf16_f32 %0, %1, %2" : "=v"(r) : "v"(lo), "v"(hi)); return r; }
typedef float f32x2 __attribute__((ext_vector_type(2)));
__device__ __forceinline__ f32x2 gelu_pk(f32x2 v) {
    const f32x2 av = __builtin_elementwise_abs(v), d = av * 0.2316418882f + 1.0f;
    f32x2 t; t.x = __builtin_amdgcn_rcpf(d.x); t.y = __builtin_amdgcn_rcpf(d.y);
    f32x2 q = t * 0.5307027145f + (-0.7265760135f); q = q * t + 0.7107068705f; q = q * t + (-0.142248368f); q = q * t + 0.127414796f; q = q * t;
    const f32x2 s = (v * v) * (-0.72134752044f);
    f32x2 e; e.x = __builtin_amdgcn_exp2f(s.x); e.y = __builtin_amdgcn_exp2f(s.y);
    const f32x2 m = v * (q * e), r = v - m;
    f32x2 o; o.x = v.x < 0.f ? m.x : r.x; o.y = v.y < 0.f ? m.y : r.y; return o;
}

template <int ACT  > struct EpiBf16 {
    static constexpr bool PERM = true, AFTER_DRAIN = false; static_assert(ACT == 0 || ACT == 1, "EpiBf16: ACT is 0 (none) or 1 (gelu_pk)");
    bf16_t* O; int ldc; const float* bias; int split_cols; size_t split_stride; float scale0;
    __device__ __forceinline__ void operator()(const f32x4 (&acc)[2][2][4][2], const Unit& u, int wr, int wc, int fr, int fq) const {
        const int row0 = u.pm * BM + wr * 64 + fr; int colt = u.pn * BM; bf16_t* base = O;
        float sc = 1.f; if (split_cols) { const int t = colt / split_cols; base += (size_t)t * split_stride; colt -= t * split_cols; if (t == 0) sc = scale0; }
        const int col0 = colt + wc * 32 + 8 * fq, bcol0 = u.pn * BM + wc * 32 + 8 * fq;
        f32x4 bv[2][2];
#pragma unroll
        for (int bj = 0; bj < 2; ++bj)
#pragma unroll
            for (int n = 0; n < 2; ++n) bv[bj][n] = bias ? *(const f32x4*)(bias + bcol0 + bj * HALF + 4 * n) : (f32x4){0.f, 0.f, 0.f, 0.f};
#pragma unroll
        for (int ai = 0; ai < 2; ++ai)
#pragma unroll
            for (int m = 0; m < 4; ++m) { bf16_t* rowp = base + (size_t)(row0 + ai * HALF + m * 16) * ldc + col0;
#pragma unroll
                for (int bj = 0; bj < 2; ++bj) { f32x4 v0 = acc[ai][bj][m][0] + bv[bj][0], v1 = acc[ai][bj][m][1] + bv[bj][1];
                    if (ACT == 1) { f32x2 a = gelu_pk((f32x2){v0[0], v0[1]}), b = gelu_pk((f32x2){v0[2], v0[3]}), c = gelu_pk((f32x2){v1[0], v1[1]}), d = gelu_pk((f32x2){v1[2], v1[3]});
                        v0 = (f32x4){a.x, a.y, b.x, b.y}; v1 = (f32x4){c.x, c.y, d.x, d.y}; }
                    v0 = v0 * sc; v1 = v1 * sc; u32x4 w; w.x = cvt_pk_bf16(v0[0], v0[1]); w.y = cvt_pk_bf16(v0[2], v0[3]); w.z = cvt_pk_bf16(v1[0], v1[1]); w.w = cvt_pk_bf16(v1[2], v1[3]);
                    *(u32x4*)(rowp + bj * HALF) = w; } }
    }
};

struct EpiSwiGLU {
    static constexpr bool PERM = true, AFTER_DRAIN = false;
    bf16_t* O; int ldc;
    __device__ __forceinline__ void operator()(const f32x4 (&acc)[2][2][4][2], const Unit& u, int wr, int wc, int fr, int fq) const {
        const int row0 = u.pm * BM + wr * 64 + fr; const int col0 = u.pn * HALF + wc * 32 + 8 * fq;
#pragma unroll
        for (int ai = 0; ai < 2; ++ai)
#pragma unroll
            for (int m = 0; m < 4; ++m) { bf16_t* rowp = O + (size_t)(row0 + ai * HALF + m * 16) * ldc + col0;
                const f32x4 g0 = acc[ai][0][m][0], g1 = acc[ai][0][m][1], u0 = acc[ai][1][m][0], u1 = acc[ai][1][m][1];
                f32x4 r0, r1;
#pragma unroll
                for (int e = 0; e < 4; ++e) {
                    r0[e] = g0[e] * __builtin_amdgcn_rcpf(1.0f + __builtin_amdgcn_exp2f(-1.4426950408889634f * g0[e])) * u0[e];
                    r1[e] = g1[e] * __builtin_amdgcn_rcpf(1.0f + __builtin_amdgcn_exp2f(-1.4426950408889634f * g1[e])) * u1[e]; }
                u32x4 w; w.x = cvt_pk_bf16(r0[0], r0[1]); w.y = cvt_pk_bf16(r0[2], r0[3]); w.z = cvt_pk_bf16(r1[0], r1[1]); w.w = cvt_pk_bf16(r1[2], r1[3]);
                *(u32x4*)rowp = w; }
    }
};

template <class Epi, class Sched, bool ALIGN_EPI = false, bool SP2 = false>
__device__ __forceinline__ void gemm_phase(PG8_LAS unsigned char* lds, const Gemm g, const Sched& S, const Epi& E) {
    const int tid = threadIdx.x, wid = __builtin_amdgcn_readfirstlane(tid >> 6), lane = tid & 63, wr = wid >> 2, wc = wid & 3, fr = lane & 15, fq = lane >> 4;
    const int K = g.K, nt = K / BK;
    unsigned voffA[2], voffB[2];
#pragma unroll
    for (int i = 0; i < 2; ++i) { int R, C; stage_rc(tid * 16 + i * 8192, R, C); const int Rb = Epi::PERM ? ((R & ~31) + perm32(R & 31)) : R;
        voffA[i] = (unsigned)(R * K + C) * 2u; voffB[i] = (unsigned)(Rb * K + C) * 2u; }
    const size_t kstep = (size_t)(BK * 2);
    const size_t hstep = (size_t)HALF * K * 2;
    const size_t tstep = 2 * hstep;
    const unsigned ldsw = (unsigned)wid * 1024u;
    const int aoff = lds_byte(wr * 64 + fr, fq * 8), boff = lds_byte(wc * 32 + fr, fq * 8);
#define PG8_SA(b, h) (((b) * 2 + (h)) * HTB)
#define PG8_SB(b, h) ((4 + (b) * 2 + (h)) * HTB)
#define PG8_STAGE(bufoff, gbase, voff) do { _Pragma("unroll") for (int _i = 0; _i < 2; ++_i) \
        __builtin_amdgcn_global_load_lds((const unsigned*)((const char*)(gbase) + (voff)[_i]), (PG8_LAS unsigned*)(lds + (bufoff) + ldsw + _i * 8192), 16, 0, 0); } while (0)
#define PG8_LDA(dst, b, h) do { _Pragma("unroll") for (int m = 0; m < 4; ++m) _Pragma("unroll") for (int k = 0; k < 2; ++k) dst[m][k] = *(const PG8_LAS bf16x8*)(lds + PG8_SA(b, h) + aoff + m * 2048 + k * 1024); } while (0)
#define PG8_LDB(dst, b, h) do { _Pragma("unroll") for (int n = 0; n < 2; ++n) _Pragma("unroll") for (int k = 0; k < 2; ++k) dst[n][k] = *(const PG8_LAS bf16x8*)(lds + PG8_SB(b, h) + boff + n * 2048 + k * 1024); } while (0)
#define PG8_MMA(ai, bj, At, Bt) do { __builtin_amdgcn_s_setprio(1); _Pragma("unroll") for (int m = 0; m < 4; ++m) _Pragma("unroll") for (int n = 0; n < 2; ++n) _Pragma("unroll") for (int k = 0; k < 2; ++k) \
        acc[ai][bj][m][n] = __builtin_amdgcn_mfma_f32_16x16x32_bf16(Bt[n][k], At[m][k], acc[ai][bj][m][n], 0, 0, 0); __builtin_amdgcn_s_setprio(0); } while (0)
#define PG8_WAIT_V(n) asm volatile("s_waitcnt vmcnt(" #n ")" ::: "memory")
#define PG8_WAIT_L(n) asm volatile("s_waitcnt lgkmcnt(" #n ")" ::: "memory")
#define PG8_BAR __builtin_amdgcn_s_barrier()
#define PG8_SCHED __builtin_amdgcn_sched_barrier(0)
    Unit cur, nxt; int ui = 0;
    if (!S.next(0, cur)) return;
    f32x4 acc[2][2][4][2];
#pragma unroll
    for (int a = 0; a < 2; ++a)
#pragma unroll
        for (int b = 0; b < 2; ++b)
#pragma unroll
            for (int m = 0; m < 4; ++m)
#pragma unroll
                for (int n = 0; n < 2; ++n) acc[a][b][m][n] = (f32x4){0.f, 0.f, 0.f, 0.f};
    bf16x8 At[4][2], B0[2][2], B1[2][2];
    const char* cA = (const char*)g.A + (size_t)cur.pa * tstep; const char* cB = (const char*)g.Bt + (size_t)cur.pb * tstep;
    S.a_ready(cur);
    if constexpr (SP2) {
        PG8_STAGE(PG8_SB(0, 0), cB, voffB); PG8_STAGE(PG8_SB(0, 1), cB + hstep, voffB); PG8_STAGE(PG8_SA(0, 0), cA, voffA); PG8_STAGE(PG8_SA(0, 1), cA + hstep, voffA);
        if (wr == 1) PG8_BAR;
        PG8_WAIT_V(2); PG8_BAR;
        PG8_STAGE(PG8_SB(1, 0), cB + kstep, voffB); PG8_STAGE(PG8_SA(1, 0), cA + kstep, voffA); PG8_STAGE(PG8_SB(1, 1), cB + hstep + kstep, voffB);
        PG8_WAIT_V(6); PG8_BAR;
    } else {
        PG8_STAGE(PG8_SB(0, 0), cB, voffB); PG8_STAGE(PG8_SA(0, 0), cA, voffA); PG8_STAGE(PG8_SB(0, 1), cB + hstep, voffB); PG8_STAGE(PG8_SA(0, 1), cA + hstep, voffA);
        if (wr == 1) PG8_BAR;
        PG8_WAIT_V(4); PG8_BAR;
        PG8_STAGE(PG8_SB(1, 0), cB + kstep, voffB); PG8_STAGE(PG8_SA(1, 0), cA + kstep, voffA); PG8_STAGE(PG8_SB(1, 1), cB + hstep + kstep, voffB);
        PG8_WAIT_V(6); PG8_BAR;
    }
    for (;;) {
        const bool has_next = S.next(ui + 1, nxt);
        const char* nA = has_next ? (const char*)g.A + (size_t)nxt.pa * tstep : cA; const char* nB = has_next ? (const char*)g.Bt + (size_t)nxt.pb * tstep : cB;
        for (int t = 0; t < nt; t += 2) {
            const bool last = (t == nt - 2);
            const char* a1 = cA + (size_t)(t + 1) * kstep;
            const char* a2 = last ? nA : cA + (size_t)(t + 2) * kstep; const char* b2 = last ? nB : cB + (size_t)(t + 2) * kstep;
            const char* a3 = a2 + kstep; const char* b3 = b2 + kstep;
            if (last && has_next) S.a_ready(nxt);
            if constexpr (SP2) {
            PG8_LDB(B0, 0, 0); PG8_LDB(B1, 0, 1); PG8_SCHED; PG8_LDA(At, 0, 0); PG8_STAGE(PG8_SA(1, 1), a1 + hstep, voffA);
            PG8_WAIT_V(8); PG8_WAIT_L(0); PG8_BAR; PG8_MMA(0, 0, At, B0); PG8_MMA(0, 1, At, B1); PG8_BAR; PG8_SCHED;
            PG8_LDA(At, 0, 1); PG8_STAGE(PG8_SB(0, 0), b2, voffB); PG8_STAGE(PG8_SB(0, 1), b2 + hstep, voffB); PG8_STAGE(PG8_SA(0, 0), a2, voffA);
            PG8_WAIT_V(8); PG8_WAIT_L(0); PG8_BAR; PG8_MMA(1, 0, At, B0); PG8_MMA(1, 1, At, B1); PG8_BAR; PG8_SCHED;
            PG8_LDB(B0, 1, 0); PG8_LDB(B1, 1, 1); PG8_SCHED; PG8_LDA(At, 1, 0); PG8_STAGE(PG8_SA(0, 1), a2 + hstep, voffA);
            PG8_WAIT_V(8); PG8_WAIT_L(0); PG8_BAR; PG8_MMA(0, 0, At, B0); PG8_MMA(0, 1, At, B1); PG8_BAR; PG8_SCHED;
            PG8_LDA(At, 1, 1); PG8_STAGE(PG8_SB(1, 0), b3, voffB); PG8_STAGE(PG8_SB(1, 1), b3 + hstep, voffB); PG8_STAGE(PG8_SA(1, 0), a3, voffA);
            PG8_WAIT_V(8); PG8_WAIT_L(0); PG8_BAR; PG8_MMA(1, 0, At, B0); PG8_MMA(1, 1, At, B1); PG8_BAR; PG8_SCHED;
            } else {
            PG8_LDB(B0, 0, 0); PG8_SCHED; PG8_LDA(At, 0, 0); PG8_STAGE(PG8_SA(1, 1), a1 + hstep, voffA);
            PG8_WAIT_L(8); PG8_BAR; PG8_WAIT_L(0); PG8_MMA(0, 0, At, B0); PG8_BAR; PG8_SCHED;
            PG8_LDB(B1, 0, 1); PG8_STAGE(PG8_SB(0, 0), b2, voffB);
            PG8_BAR; PG8_WAIT_L(0); PG8_MMA(0, 1, At, B1); PG8_BAR;
            PG8_LDA(At, 0, 1); PG8_STAGE(PG8_SA(0, 0), a2, voffA);
            PG8_BAR; PG8_WAIT_L(0); PG8_MMA(1, 0, At, B0); PG8_BAR; PG8_SCHED;
            PG8_STAGE(PG8_SB(0, 1), b2 + hstep, voffB);
            PG8_WAIT_V(6); PG8_BAR; PG8_MMA(1, 1, At, B1); PG8_BAR;
            PG8_LDB(B0, 1, 0); PG8_SCHED; PG8_LDA(At, 1, 0); PG8_STAGE(PG8_SA(0, 1), a2 + hstep, voffA);
            PG8_WAIT_L(8); PG8_BAR; PG8_WAIT_L(0); PG8_MMA(0, 0, At, B0); PG8_BAR; PG8_SCHED;
            PG8_LDB(B1, 1, 1); PG8_STAGE(PG8_SB(1, 0), b3, voffB);
            PG8_BAR; PG8_WAIT_L(0); PG8_MMA(0, 1, At, B1); PG8_BAR;
            PG8_LDA(At, 1, 1); PG8_STAGE(PG8_SA(1, 0), a3, voffA);
            PG8_BAR; PG8_WAIT_L(0); PG8_MMA(1, 0, At, B0); PG8_BAR; PG8_SCHED;
            PG8_STAGE(PG8_SB(1, 1), b3 + hstep, voffB);
            PG8_WAIT_V(6); PG8_BAR; PG8_MMA(1, 1, At, B1); PG8_BAR;
            }
        }
        if constexpr (ALIGN_EPI) { if (wr == 0) PG8_BAR; }
        if constexpr (!Epi::AFTER_DRAIN) { E(acc, cur, wr, wc, fr, fq); S.done(cur); }
        if (!has_next) break;
#pragma unroll
        for (int a = 0; a < 2; ++a)
#pragma unroll
            for (int b = 0; b < 2; ++b)
#pragma unroll
                for (int m = 0; m < 4; ++m)
#pragma unroll
                    for (int n = 0; n < 2; ++n) acc[a][b][m][n] = (f32x4){0.f, 0.f, 0.f, 0.f};
        cur = nxt; cA = nA; cB = nB; ++ui;
        if constexpr (ALIGN_EPI) { if (wr == 1) PG8_BAR; }
    }
    PG8_WAIT_V(0);
    if constexpr (!ALIGN_EPI) { if (wr == 0) PG8_BAR; }
    PG8_BAR;
    if constexpr (Epi::AFTER_DRAIN) { E.fused(acc, cur, wr, wc, fr, fq, lds, wid, lane); S.done(cur); }
#undef PG8_SA
#undef PG8_SB
#undef PG8_STAGE
#undef PG8_LDA
#undef PG8_LDB
#undef PG8_MMA
#undef PG8_WAIT_V
#undef PG8_WAIT_L
#undef PG8_BAR
#undef PG8_SCHED
}
}

#include <hip/hip_bf16.h>
#include <cmath>
namespace attn_body {
using bf16=__hip_bfloat16;
using bf16x8=__attribute__((ext_vector_type(8)))short;
using s16x4=__attribute__((ext_vector_type(4)))short;
using f32x16=__attribute__((ext_vector_type(16)))float;
using u32x4=__attribute__((ext_vector_type(4)))unsigned;
constexpr int D=64,QP=1536,KP=1536,OP=1024,NKEYS=16640;
constexpr int NW=8,QBLK=32,QB=QBLK*NW,KVBLK=64;
constexpr int ATTN_UNIT_ROWS=QB;
__device__ __forceinline__ int crow(int r,int hi){return (r&3)+8*(r>>2)+4*hi;}
#define SBAR() __builtin_amdgcn_sched_barrier(0)
__device__ __forceinline__ void cmask(f32x16&p0,f32x16&p1,int jb,int qrel,int hi){
  const float NEG=-INFINITY; int kb=64*jb+4*hi;
  #pragma unroll
  for(int r=0;r<16;++r){int kv=kb+(r&3)+8*(r>>2); if(kv>qrel)p0[r]=NEG; if(kv+32>qrel)p1[r]=NEG;}
}

constexpr int NSLOT=3, SLOTB=8192;
constexpr int LDS_K=0, LDS_V=NSLOT*SLOTB, LDS_WS=2*NSLOT*SLOTB, LDS_OST=LDS_WS+NW*64*4, LDS_BYTES=LDS_OST+NW*4096;
constexpr float C2=0.125f*1.4426950408889634f;
__device__ __forceinline__ void glds16(const void*gsrc,unsigned lds_dst){unsigned keep;
  asm volatile("s_mov_b32 %0, m0\n\ts_mov_b32 m0, %2\n\ts_nop 0\n\tglobal_load_lds_dwordx4 %1, off\n\ts_mov_b32 m0, %0":"=&s"(keep):"v"(gsrc),"s"(lds_dst):"memory");}
__device__ __forceinline__ float max3f(float a,float b,float c){float r;asm("v_max3_f32 %0, %1, %2, %3":"=v"(r):"v"(a),"v"(b),"v"(c));return r;}
__device__ __forceinline__ float max2f(float a,float b){float r;asm("v_max_f32_e32 %0, %1, %2":"=v"(r):"v"(a),"v"(b));return r;}
__device__ __forceinline__ float fadd_s(float a,float b){float r;asm("v_add_f32_e32 %0, %1, %2":"=v"(r):"v"(a),"v"(b));return r;}
__device__ __forceinline__ float fsub_s(float a,float b){float r;asm("v_sub_f32_e32 %0, %1, %2":"=v"(r):"v"(a),"v"(b));return r;}
typedef float f32x2_t __attribute__((ext_vector_type(2))); typedef __bf16 bf16x2_t __attribute__((ext_vector_type(2)));
__device__ __forceinline__ unsigned cvtpk_s(float lo,float hi){f32x2_t v={lo,hi};bf16x2_t b=__builtin_convertvector(v,bf16x2_t);return __builtin_bit_cast(unsigned,b);}
#define WAIT_BAR(N) asm volatile("s_waitcnt vmcnt(" #N ") lgkmcnt(0)\n\ts_barrier":::"memory")

__device__ __forceinline__ void qkt(f32x16&p0,f32x16&p1,const char*Kslot,const bf16x8*qr,const f32x16&negm,int r32,int hi){
  const char*kb=Kslot+hi*1024+r32*16;
  #pragma unroll
  for(int d0=0;d0<4;++d0){
    const bf16x8 b0=*reinterpret_cast<const bf16x8*>(kb+d0*2048);
    const bf16x8 b1=*reinterpret_cast<const bf16x8*>(kb+d0*2048+512);
    if(d0==0){p0=__builtin_amdgcn_mfma_f32_32x32x16_bf16(b0,qr[0],negm,0,0,0);p1=__builtin_amdgcn_mfma_f32_32x32x16_bf16(b1,qr[0],negm,0,0,0);}
    else{p0=__builtin_amdgcn_mfma_f32_32x32x16_bf16(b0,qr[d0],p0,0,0,0);p1=__builtin_amdgcn_mfma_f32_32x32x16_bf16(b1,qr[d0],p1,0,0,0);}}
}
typedef __attribute__((address_space(3))) const char* lds_cptr;
typedef short v4i16_t __attribute__((ext_vector_type(4)));
__device__ __forceinline__ void kload8(bf16x8*kf,lds_cptr kp){
  kf[0]=*(const __attribute__((address_space(3))) bf16x8*)(kp);      kf[1]=*(const __attribute__((address_space(3))) bf16x8*)(kp+512);
  kf[2]=*(const __attribute__((address_space(3))) bf16x8*)(kp+2048); kf[3]=*(const __attribute__((address_space(3))) bf16x8*)(kp+2560);
  kf[4]=*(const __attribute__((address_space(3))) bf16x8*)(kp+4096); kf[5]=*(const __attribute__((address_space(3))) bf16x8*)(kp+4608);
  kf[6]=*(const __attribute__((address_space(3))) bf16x8*)(kp+6144); kf[7]=*(const __attribute__((address_space(3))) bf16x8*)(kp+6656);
}
__device__ __forceinline__ void kload2(bf16x8*kf,lds_cptr kp,int j){ kf[2*j]=*(const __attribute__((address_space(3))) bf16x8*)(kp+j*2048); kf[2*j+1]=*(const __attribute__((address_space(3))) bf16x8*)(kp+j*2048+512); }
__device__ __forceinline__ s16x4 vtr(lds_cptr p){ return __builtin_bit_cast(s16x4,__builtin_amdgcn_ds_read_tr16_b64_v4i16((__attribute__((address_space(3))) v4i16_t*)p)); }
__device__ __forceinline__ float rowmax(const f32x16&p0,const f32x16&p1){
  float a=max3f(p0[0],p0[1],p1[0]),b=max3f(p0[2],p0[3],p1[1]);a=max3f(a,p1[2],p1[3]);
  #pragma unroll
  for(int r=4;r<16;r+=4){a=max3f(a,p0[r],p0[r+1]);b=max3f(b,p0[r+2],p0[r+3]);a=max3f(a,p1[r],p1[r+1]);b=max3f(b,p1[r+2],p1[r+3]);}
  const float m=max2f(a,b);
  auto rr=__builtin_amdgcn_permlane32_swap(__float_as_uint(m),__float_as_uint(m),false,false);
  return max2f(__uint_as_float(rr[0]),__uint_as_float(rr[1]));
}
__device__ __forceinline__ void pv(f32x16*o,int vb,bf16x8 pa0,bf16x8 pa1,bf16x8 pa2,bf16x8 pa3){
  #pragma unroll
  for(int d0=0;d0<2;++d0){s16x4 lo[4],hi[4];
    #pragma unroll
    for(int ks=0;ks<4;++ks){
      asm volatile("ds_read_b64_tr_b16 %0,%1 offset:%c2":"=&v"(lo[ks]):"v"(vb),"i"(d0*4096+ks*1024):"memory");
      asm volatile("ds_read_b64_tr_b16 %0,%1 offset:%c2":"=&v"(hi[ks]):"v"(vb),"i"(d0*4096+ks*1024+512):"memory");}
    asm volatile("s_waitcnt lgkmcnt(0)":::"memory");SBAR();
    #define PK(k) (bf16x8){lo[k][0],lo[k][1],lo[k][2],lo[k][3],hi[k][0],hi[k][1],hi[k][2],hi[k][3]}
    o[d0]=__builtin_amdgcn_mfma_f32_32x32x16_bf16(pa0,PK(0),o[d0],0,0,0);
    o[d0]=__builtin_amdgcn_mfma_f32_32x32x16_bf16(pa1,PK(1),o[d0],0,0,0);
    o[d0]=__builtin_amdgcn_mfma_f32_32x32x16_bf16(pa2,PK(2),o[d0],0,0,0);
    o[d0]=__builtin_amdgcn_mfma_f32_32x32x16_bf16(pa3,PK(3),o[d0],0,0,0);
    #undef PK
  }
}

#ifndef ATTN_STORE16
#define ATTN_STORE16(p,v) (*(u32x4*)(p)=(v))
#endif
template<int THRL> __device__ __forceinline__ void attn_unit(int hq,int kvh,int qb,const bf16*Q,const bf16*__restrict__ K,const bf16*__restrict__ V,bf16*O,char*shm){
  const int tid=threadIdx.x,lane=tid&63,r32=lane&31,hi=lane>>5; const int wid=__builtin_amdgcn_readfirstlane(tid>>6);
  const int q0=qb*QB;
  const bf16*Qw=Q+(long)(q0+wid*QBLK)*QP+hq*D;
  const bf16*Kh=K+kvh*D,*Vh=V+kvh*D;
  const unsigned lds0=(unsigned)(uintptr_t)shm;
  float*wsf=(float*)(shm+LDS_WS)+wid*64;
  const bf16*ksrc=Kh+(long)lane*KP+wid*8;
  const bf16*vsrc=Vh+(long)(16*(wid&3)+(lane>>2))*KP+(wid>>2)*32+(lane&3)*8;
  const unsigned kdst=lds0+LDS_K+wid*1024, vdst=lds0+LDS_V+wid*1024;
  #define DMA_K(t,slot) glds16(ksrc+(long)(t)*KVBLK*KP,(unsigned)__builtin_amdgcn_readfirstlane(kdst+(slot)))
  #define DMA_V(t,slot) glds16(vsrc+(long)(t)*KVBLK*KP,(unsigned)__builtin_amdgcn_readfirstlane(vdst+(slot)))
  const int vb0=(int)(lds0+LDS_V)+((lane>>4)&1)*32+(lane&3)*8+(4*hi+((lane&15)>>2))*64;
  const char*Kbase=shm+LDS_K; bf16x8 kf[8];
  const lds_cptr shm3=(lds_cptr)shm; const lds_cptr kp0=shm3+LDS_K+hi*1024+r32*16; const lds_cptr vp0=shm3+LDS_V+((lane>>4)&1)*32+(lane&3)*8+(4*hi+((lane&15)>>2))*64;
  const int NT=NKEYS/KVBLK;
  DMA_K(0,0);DMA_V(0,0);DMA_K(1,SLOTB);
  bf16x8 qr[4];
  #pragma unroll
  for(int d0=0;d0<4;++d0)qr[d0]=*reinterpret_cast<const bf16x8*>(&Qw[(long)r32*QP+d0*16+hi*8]);
  float mhat=0.f,l_reg=0.f;f32x16 o[2];o[0]=f32x16{};o[1]=f32x16{};f32x16 negm=f32x16{};asm volatile("":"+v"(negm));
    #define CMASK(P0,P1,t) do{}while(0)
  bool resc=false;
  #define START(P0,P1) do{ const float rm=rowmax(P0,P1); resc=false; \
    { const float dl=rm; mhat=fadd_s(mhat,dl); \
      _Pragma("unroll") for(int r=0;r<16;++r){P0[r]=fsub_s(P0[r],dl);P1[r]=fsub_s(P1[r],dl);} \
      _Pragma("unroll") for(int r=0;r<16;++r)negm[r]=-mhat; asm volatile("":"+v"(negm)); } \
    _Pragma("unroll") for(int r=0;r<16;++r)P0[r]=__builtin_amdgcn_exp2f(P0[r]); }while(0)
  #define RESC() do{ if(resc){ asm volatile("s_waitcnt lgkmcnt(0)":::"memory"); \
      _Pragma("unroll") for(int d_=0;d_<2;++d_) _Pragma("unroll") for(int r=0;r<16;++r)o[d_][r]*=wsf[crow(r,hi)]; } }while(0)
  f32x16 pA0,pA1,pB0,pB1;
  int sl_prev=0,sl_cur=0,sl_next=SLOTB;
  #define ROT() do{sl_prev=sl_cur;sl_cur=sl_next;sl_next=(sl_next==(NSLOT-1)*SLOTB)?0:sl_next+SLOTB;}while(0)
  DMA_K(2,2*SLOTB);
  WAIT_BAR(3);
  qkt(pA0,pA1,Kbase,qr,negm,r32,hi);asm volatile("s_nop 15\n\ts_nop 7":"+v"(pA0),"+v"(pA1));CMASK(pA0,pA1,0);
  START(pA0,pA1);
  _Pragma("unroll") for(int r=0;r<16;++r)pA1[r]=__builtin_amdgcn_exp2f(pA1[r]);
  WAIT_BAR(0);
  DMA_K(3,0);DMA_V(1,SLOTB);
  ROT();
  kload8(kf,kp0+sl_cur);
  WAIT_BAR(2);
  s16x4 vlo[8],vhi[8]; u32x4 pw0,pw1,pw2,pw3;
  #define PKW(P,B) cvtpk_s(P[B],P[B+1])
  #define PAF(k) __builtin_bit_cast(bf16x8,pw##k)
  #define VFR(i) (bf16x8){vlo[i][0],vlo[i][1],vlo[i][2],vlo[i][3],vhi[i][0],vhi[i][1],vhi[i][2],vhi[i][3]}
  #define PIN(x) asm volatile("":"+v"(x))
  #define MX3(a,b,c) __builtin_fmaxf(__builtin_fmaxf((a),(b)),(c))
  #define GAPA(MF,A0,A1,A2,A3,W0,W1,PW) do{ MF; sacc+=A0; sacc+=A1; sacc+=A2; sacc+=A3; PIN(sacc); W0; W1; PIN(PW); SBAR(); }while(0)
  #define EX(v) __builtin_amdgcn_exp2f(v)
  #define GAPB(MF,X,B) do{ MF; X[B]=EX(X[B]); X[B+1]=EX(X[B+1]); X[B+2]=EX(X[B+2]); X[B+3]=EX(X[B+3]); PIN(X); SBAR(); }while(0)
  #define VRD(i) do{ vlo[i]=vtr(vp_+(((i)>>2)*4096+((i)&3)*1024)); vhi[i]=vtr(vp_+(((i)>>2)*4096+((i)&3)*1024+512)); }while(0)
  #define KRD(G,j) do{ if(G){ kload2(kf,kp0+sl_next,j); SBAR(); } }while(0)
  #define STEP(C0,C1,P0,P1,t,GK,GV,GL) do{ SBAR(); \
    const lds_cptr vp_=vp0+sl_prev; \
    VRD(0); SBAR(); float sacc=(P0[0]+P0[1]); \
    GAPA(C0=__builtin_amdgcn_mfma_f32_32x32x16_bf16(kf[0],qr[0],negm,0,0,0), P0[2],P0[3],P0[4],P0[5],     pw0[0]=PKW(P0,0), pw0[1]=PKW(P0,2), pw0); \
    VRD(4); SBAR(); GAPA(C1=__builtin_amdgcn_mfma_f32_32x32x16_bf16(kf[1],qr[0],negm,0,0,0), P0[6],P0[7],P0[8],P0[9],     pw0[2]=PKW(P0,4), pw0[3]=PKW(P0,6), pw0); \
    VRD(1); SBAR(); GAPA(C0=__builtin_amdgcn_mfma_f32_32x32x16_bf16(kf[2],qr[1],C0,0,0,0),   P0[10],P0[11],P0[12],P0[13], pw1[0]=PKW(P0,8), pw1[1]=PKW(P0,10), pw1); \
    VRD(5); SBAR(); GAPA(C1=__builtin_amdgcn_mfma_f32_32x32x16_bf16(kf[3],qr[1],C1,0,0,0),   P0[14],P0[15],P1[0],P1[1],   pw1[2]=PKW(P0,12),pw1[3]=PKW(P0,14), pw1); \
    VRD(2); SBAR(); GAPA(C0=__builtin_amdgcn_mfma_f32_32x32x16_bf16(kf[4],qr[2],C0,0,0,0),   P1[2],P1[3],P1[4],P1[5],     pw2[0]=PKW(P1,0), pw2[1]=PKW(P1,2), pw2); \
    VRD(6); SBAR(); GAPA(C1=__builtin_amdgcn_mfma_f32_32x32x16_bf16(kf[5],qr[2],C1,0,0,0),   P1[6],P1[7],P1[8],P1[9],     pw2[2]=PKW(P1,4), pw2[3]=PKW(P1,6), pw2); \
    VRD(3); SBAR(); GAPA(C0=__builtin_amdgcn_mfma_f32_32x32x16_bf16(kf[6],qr[3],C0,0,0,0),   P1[10],P1[11],P1[12],P1[13], pw3[0]=PKW(P1,8), pw3[1]=PKW(P1,10), pw3); \
    VRD(7); SBAR(); GAPA(C1=__builtin_amdgcn_mfma_f32_32x32x16_bf16(kf[7],qr[3],C1,0,0,0),   P1[14],P1[15],0.f,0.f,       pw3[2]=PKW(P1,12),pw3[3]=PKW(P1,14), pw3); \
    l_reg+=sacc; \
    if(GK){DMA_K((t)+3,sl_cur);} if(GV){DMA_V((t)+1,sl_next);} \
    CMASK(C0,C1,t); \
    { float a=MX3(C0[0],C0[1],C1[0]),b=MX3(C0[2],C0[3],C1[1]); a=MX3(a,C1[2],C1[3]); \
      _Pragma("unroll") for(int r=4;r<16;r+=4){a=MX3(a,C0[r],C0[r+1]);b=MX3(b,C0[r+2],C0[r+3]);a=MX3(a,C1[r],C1[r+1]);b=MX3(b,C1[r+2],C1[r+3]);} \
      float rm=__builtin_fmaxf(a,b); { auto rr=__builtin_amdgcn_permlane32_swap(__float_as_uint(rm),__float_as_uint(rm),false,false); rm=__builtin_fmaxf(__uint_as_float(rr[0]),__uint_as_float(rr[1])); } \
      resc=false; \
      if(__builtin_expect(__any(rm>(float)THRL),0)){ const float dl=__builtin_fmaxf(rm,0.f); mhat+=dl; \
        _Pragma("unroll") for(int r=0;r<16;++r){C0[r]-=dl;C1[r]-=dl;} \
        _Pragma("unroll") for(int r=0;r<16;++r)negm[r]=-mhat; asm volatile("":"+v"(negm)); \
        const float f=__builtin_amdgcn_exp2f(-dl); l_reg*=f; if(hi==0)wsf[r32]=f; resc=true; } } \
    SBAR(); \
    GAPB(o[0]=__builtin_amdgcn_mfma_f32_32x32x16_bf16(PAF(0),VFR(0),o[0],0,0,0), C0,0); \
    GAPB(o[1]=__builtin_amdgcn_mfma_f32_32x32x16_bf16(PAF(0),VFR(4),o[1],0,0,0), C0,4); \
    KRD(GL,0); GAPB(o[0]=__builtin_amdgcn_mfma_f32_32x32x16_bf16(PAF(1),VFR(1),o[0],0,0,0), C0,8); \
    KRD(GL,1); GAPB(o[1]=__builtin_amdgcn_mfma_f32_32x32x16_bf16(PAF(1),VFR(5),o[1],0,0,0), C0,12); \
    KRD(GL,2); GAPB(o[0]=__builtin_amdgcn_mfma_f32_32x32x16_bf16(PAF(2),VFR(2),o[0],0,0,0), C1,0); \
    KRD(GL,3); GAPB(o[1]=__builtin_amdgcn_mfma_f32_32x32x16_bf16(PAF(2),VFR(6),o[1],0,0,0), C1,4); \
    GAPB(o[0]=__builtin_amdgcn_mfma_f32_32x32x16_bf16(PAF(3),VFR(3),o[0],0,0,0), C1,8); \
    GAPB(o[1]=__builtin_amdgcn_mfma_f32_32x32x16_bf16(PAF(3),VFR(7),o[1],0,0,0), C1,12); \
    }while(0)
  int t=1;
  #undef CMASK
  #define CMASK(P0,P1,t) do{}while(0)
  for(;t+5<NT;t+=2){
    STEP(pB0,pB1,pA0,pA1,t,true,true,true);     WAIT_BAR(2); RESC(); ROT();
    STEP(pA0,pA1,pB0,pB1,t+1,true,true,true);   WAIT_BAR(2); RESC(); ROT();
  }
  #undef CMASK
  #define CMASK(P0,P1,t) do{}while(0)
  #define ENDW(tt) do{ if((tt)+3<NT){WAIT_BAR(2);} else if((tt)+2<NT){WAIT_BAR(1);} else {WAIT_BAR(0);} }while(0)
  for(;t+1<NT;t+=2){
    STEP(pB0,pB1,pA0,pA1,t,(t+3<NT),(t+1<NT),(t+1<NT));       ENDW(t);   RESC(); ROT();
    STEP(pA0,pA1,pB0,pB1,t+1,(t+4<NT),(t+2<NT),(t+2<NT));     ENDW(t+1); RESC(); ROT();
  }
  STEP(pB0,pB1,pA0,pA1,NT-1,false,false,false); RESC();
  { float sacc=pB0[0]+pB0[1]; _Pragma("unroll") for(int r=2;r<16;++r)sacc+=pB0[r]; _Pragma("unroll") for(int r=0;r<16;++r)sacc+=pB1[r]; l_reg+=sacc;
    pw0=(u32x4){PKW(pB0,0),PKW(pB0,2),PKW(pB0,4),PKW(pB0,6)};pw1=(u32x4){PKW(pB0,8),PKW(pB0,10),PKW(pB0,12),PKW(pB0,14)};pw2=(u32x4){PKW(pB1,0),PKW(pB1,2),PKW(pB1,4),PKW(pB1,6)};pw3=(u32x4){PKW(pB1,8),PKW(pB1,10),PKW(pB1,12),PKW(pB1,14)};
    SBAR(); pv(o,vb0+sl_cur,PAF(0),PAF(1),PAF(2),PAF(3)); }
  #undef PKW
  #undef PAF
  #undef VFR
  #undef PIN
  #undef MX3
  #undef GAPA
  #undef GAPB
  #undef EX
  #undef VRD
  #undef KRD
  #undef STEP
  #undef ENDW
  {auto rr=__builtin_amdgcn_permlane32_swap(__float_as_uint(l_reg),__float_as_uint(l_reg),false,false);l_reg=__uint_as_float(rr[0])+__uint_as_float(rr[1]);}
  if(hi==0)wsf[32+r32]=l_reg;asm volatile("s_waitcnt lgkmcnt(0)":::"memory");
  float rli[16];
  #pragma unroll
  for(int r=0;r<16;++r)rli[r]=__builtin_amdgcn_rcpf(wsf[32+crow(r,hi)]);
  bf16*Ow=O+(long)(q0+wid*QBLK)*OP+hq*D;
  { bf16*stg=(bf16*)(shm+LDS_OST)+wid*2048;
    #pragma unroll
    for(int r=0;r<16;++r){const int orow=crow(r,hi);
      #pragma unroll
      for(int d0=0;d0<2;++d0)stg[orow*64+d0*32+r32]=__float2bfloat16(o[d0][r]*rli[r]);}
    asm volatile("s_waitcnt lgkmcnt(0)":::"memory");
    #pragma unroll
    for(int i=0;i<4;++i){const int row=i*8+(lane>>3),ch=lane&7; const u32x4 v=*(const u32x4*)(stg+row*64+ch*8); ATTN_STORE16(Ow+(long)row*OP+ch*8,v);} }
  asm volatile("s_waitcnt lgkmcnt(0)\n\ts_barrier":::"memory");
  #undef DMA_K
  #undef DMA_V
  #undef CMASK
  #undef START
  #undef RESC
  #undef ROT
}
constexpr int ATTN_LDS_BYTES=LDS_BYTES;
struct AttnTensors { const bf16* Q; const bf16* K; const bf16* V; bf16* O; };
struct AttnUnit { int hq; int kvh; int qb; };
struct GqaOrder {
  int vcu;
  __device__ __forceinline__ explicit GqaOrder(int grid,int block):vcu((block%8)*(grid/8)+block/8){}
  __device__ __forceinline__ bool next(int i,AttnUnit&u)const{ if(i>=3)return false; const int x=vcu>>5; u.kvh=x>>1; u.hq=u.kvh*3+i; u.qb=(x&1)*32+(vcu&31); return true; }
};
template<class Sched,int THRL=8> __device__ __forceinline__ void attn_phase(char*lds,const AttnTensors&T,const Sched&S){
  AttnUnit u;
  for(int i=0;S.next(i,u);++i){ attn_unit<THRL>(u.hq,u.kvh,u.qb,T.Q,T.K,T.V,T.O,lds); }
}
#undef SBAR
#undef WAIT_BAR
}


constexpr int NWAVES = 8;
#ifndef MK_N_LAUNCHES
#define MK_N_LAUNCHES 1
#endif
constexpr int NPH = 20;

constexpr int SEQ = 16384, DMODEL = 1024, CTXL = 256, MROWS = SEQ + CTXL;
constexpr int NQKVF = 1536, KCOL = 768, VCOL = 1024, FCOL = 1280;
constexpr int DFF = 2816, DEXP = 3584, NEXP = 8;
constexpr int MOE_TILES_MAX = 136, MOE_PASS_TILES = 68;
constexpr float NEPS = 1e-6f;

constexpr size_t MiB = 1u << 20;
constexpr size_t WS_CTL = 0, CTL_ZERO_BYTES = 1 * MiB;
constexpr size_t WS_SMALL = 1 * MiB;
constexpr size_t SM_MOD0 = 0, SM_MOD1 = 32768, SM_CMOD = 65536, SM_BLKCNT = 81920, SM_TILEE = 98304, SM_TOKE = 131072, SM_TOKW = 262144, SM_TOKR = 393216, SM_TOKP = 524288;
constexpr size_t WS_WIN0 = 4 * MiB, WS_WOUT0 = 7 * MiB, WS_WGU0 = 9 * MiB, WS_WDN0 = 20 * MiB, WS_WIN1 = 26 * MiB, WS_WOUT1 = 32 * MiB, WS_WEGU = 34 * MiB, WS_WEDN = 146 * MiB;
constexpr size_t WS_H = 202 * MiB, WS_QKVF = 235 * MiB, WS_PB = 284 * MiB, WS_QB = 292 * MiB, WS_MIX = 300 * MiB, WS_Y = 332 * MiB;
constexpr size_t WS_ACT0 = 235 * MiB, WS_BCU = 235 * MiB, WS_VB = 364 * MiB;
constexpr size_t WS_HPERM = 235 * MiB, WS_YP = 303 * MiB, WS_ACT1 = 371 * MiB, WS_END = 490 * MiB;
static_assert(WS_WEDN + (size_t)NEXP * DMODEL * DEXP * 2 <= WS_H, "weights");
static_assert(WS_H + (size_t)MROWS * DMODEL * 2 <= WS_QKVF && WS_QKVF + (size_t)MROWS * NQKVF * 2 <= WS_PB && WS_MIX + (size_t)SEQ * DMODEL * 2 <= WS_Y, "layer-0 mixer map");
static_assert(WS_ACT0 + (size_t)SEQ * DFF * 2 <= WS_Y && WS_BCU + (size_t)SEQ * 3 * DMODEL * 2 <= WS_Y && WS_Y + (size_t)SEQ * DMODEL * 2 <= WS_VB, "ffn / conv map");
static_assert(WS_HPERM + (size_t)MOE_TILES_MAX * 256 * DMODEL * 2 <= WS_YP && WS_YP + (size_t)MOE_TILES_MAX * 256 * DMODEL * 2 <= WS_ACT1 && WS_ACT1 + (size_t)MOE_PASS_TILES * 256 * DEXP * 2 <= WS_END, "moe map");
constexpr int CW_BAR = 4096;

constexpr int RING_OFF = 0, RING_BYTES = 131072;
constexpr int LDSCTL_OFF = RING_BYTES;
constexpr int LDS_BYTES = 147456;

#define GAS __attribute__((address_space(1)))
#define LAS __attribute__((address_space(3)))
typedef unsigned short bf16;
typedef unsigned v4u __attribute__((ext_vector_type(4)));
typedef unsigned v2u __attribute__((ext_vector_type(2)));
typedef float f32x4 __attribute__((ext_vector_type(4)));
typedef short bf16x8 __attribute__((ext_vector_type(8)));
typedef GAS unsigned gu32;
__device__ __forceinline__ unsigned f2bf(float f) { unsigned u = __builtin_bit_cast(unsigned, f); return (u + 0x7fffu + ((u >> 16) & 1u)) >> 16; }
__device__ __forceinline__ unsigned pk2(float lo, float hi) { return f2bf(lo) | (f2bf(hi) << 16); }
__device__ __forceinline__ float bflo(unsigned w) { return __builtin_bit_cast(float, w << 16); }
__device__ __forceinline__ float bfhi(unsigned w) { return __builtin_bit_cast(float, w & 0xffff0000u); }
__device__ __forceinline__ float fast_exp(float x) { return __builtin_amdgcn_exp2f(x * 1.4426950408889634f); }
__device__ __forceinline__ float silu_f(float x) { return x * __builtin_amdgcn_rcpf(1.0f + fast_exp(-x)); }
__device__ __forceinline__ float wave_sum(float v) {
#pragma unroll
    for (int o = 1; o < 64; o <<= 1) v += __shfl_xor(v, o);
    return v;
}
__device__ __forceinline__ float sum4(f32x4 v) { return (v.x + v.y) + (v.z + v.w); }
__device__ __forceinline__ f32x4 ld_bf4(const bf16* p) { const v2u w = *(const v2u*)p; return (f32x4){bflo(w.x), bfhi(w.x), bflo(w.y), bfhi(w.y)}; }
__device__ __forceinline__ void st_bf4(bf16* p, f32x4 v) { v2u w; w.x = pk2(v.x, v.y); w.y = pk2(v.z, v.w); *(v2u*)p = w; }

#define XB_TMO      128
#define XB_XCNT(j)  (256  + 64 * (j))
#define XB_XSUB(j)  (1280 + 64 * (j))
#define XB_XGEN(j)  (2304 + 64 * (j))
#define XB_TOP      3328
#define XB_TOPGEN   3392
#define XCD_BAR_WORDS 3456
#define XB_SPIN_CAP (1u << 18)

__device__ __forceinline__ unsigned xb_ld(unsigned* p)              { return __hip_atomic_load(p, __ATOMIC_RELAXED, __HIP_MEMORY_SCOPE_AGENT); }
__device__ __forceinline__ unsigned xb_add(unsigned* p, unsigned v) { return __hip_atomic_fetch_add(p, v, __ATOMIC_RELAXED, __HIP_MEMORY_SCOPE_AGENT); }
__device__ __forceinline__ unsigned xb_xcc_id() { return (unsigned)__builtin_amdgcn_s_getreg((3 << 11) | 20) & 0xFu; }
#define XB_SPIN(cond, bar) do { unsigned _sp = 0; while (cond) { __builtin_amdgcn_s_sleep(1); \
    if ((++_sp & 255u) == 0u) { if (xb_ld(&(bar)[XB_TMO])) break; if (_sp > XB_SPIN_CAP) { atomicAdd(&(bar)[XB_TMO], 1u); break; } } } } while (0)

struct XcdBarrier {
    unsigned* bar; unsigned x;
    volatile LAS unsigned* st;
};

__device__ __forceinline__ XcdBarrier xcd_barrier_post(unsigned* bar, volatile LAS unsigned* st) {
    XcdBarrier b; b.bar = bar; b.x = xb_xcc_id(); b.st = st;
    if (threadIdx.x == 0) (void)xb_add(&bar[XB_XCNT(b.x)], 1u);
    return b;
}
__device__ __forceinline__ void xcd_barrier_complete(unsigned* bar, unsigned x, unsigned& nloc, unsigned& nx) {
    const unsigned G = gridDim.x * gridDim.y * gridDim.z;
    unsigned sum, cnt, mine, sp = 0u;
    for (;;) {
        sum = 0u; cnt = 0u; mine = 0u;
#pragma unroll
        for (unsigned j = 0; j < 16; ++j) { const unsigned c = xb_ld(&bar[XB_XCNT(j)]); sum += c; cnt += (c > 0u) ? 1u : 0u; mine = (j == x) ? c : mine; }
        if (sum == G) break;
        __builtin_amdgcn_s_sleep(1);
        if ((++sp & 255u) == 0u) { if (xb_ld(&bar[XB_TMO])) break; if (sp > XB_SPIN_CAP) { atomicAdd(&bar[XB_TMO], 1u); break; } }
    }
    nloc = mine > 0u ? mine : 1u; nx = cnt > 0u ? cnt : 1u;
}

__device__ __forceinline__ void xcd_barrier(const XcdBarrier& b) {
    asm volatile("s_waitcnt vmcnt(0)" ::: "memory");
    __syncthreads();
    if (threadIdx.x == 0) {
        unsigned* bar = b.bar;
        __builtin_amdgcn_s_waitcnt(0);
        unsigned nloc = b.st[0], nx = b.st[1];
        if (nloc == 0u) { xcd_barrier_complete(bar, b.x, nloc, nx); b.st[0] = nloc; b.st[1] = nx; }
        const unsigned old = xb_add(&bar[XB_XSUB(b.x)], 1u);
        const unsigned gen = old / nloc;
        if (old + 1u == (gen + 1u) * nloc) {
            __builtin_amdgcn_fence(__ATOMIC_RELEASE, "agent");
            asm volatile("s_waitcnt vmcnt(0)" ::: "memory");
            const unsigned og = xb_add(&bar[XB_TOP], 1u);
            const unsigned tg = og / nx;
            if (og + 1u == (tg + 1u) * nx) xb_add(&bar[XB_TOPGEN], 1u);
            else XB_SPIN(xb_ld(&bar[XB_TOPGEN]) == tg, bar);
            __builtin_amdgcn_fence(__ATOMIC_ACQUIRE, "agent");
            xb_add(&bar[XB_XGEN(b.x)], 1u);
            asm volatile("s_waitcnt vmcnt(0)" ::: "memory");
        } else {
            XB_SPIN(xb_ld(&bar[XB_XGEN(b.x)]) == gen, bar);
            __builtin_amdgcn_fence(__ATOMIC_ACQUIRE, "agent");
            asm volatile("s_waitcnt vmcnt(0)" ::: "memory");
        }
    }
    __syncthreads();
}


struct Ctx {
    LAS unsigned char* lds;
    int tid, lane, wave, vcu, G, blk;
    const float* in[21]; float* out; unsigned char* ws;
};
#define WSP(T, off) ((T*)(C.ws + (off)))
#define SMP(T, off) ((T*)(C.ws + WS_SMALL + (off)))

__device__ __forceinline__ void p0_transpose_item(const float* W, int K, int N, bf16* WT, int inter, int up, LAS float* scr, int item, int lane) {
    const int nblk = N / 32, kb = item / nblk, nb = item % nblk, k0 = 64 * kb, n0 = 32 * nb;
    const int drow0 = inter ? ((n0 >> 7) * 256 + (n0 & 127) + (up ? 128 : 0)) : n0;
#pragma unroll 8
    for (int i = 0; i < 32; ++i) { const int kk = 2 * i + (lane >> 5); scr[kk * 33 + (lane & 31)] = W[(size_t)(k0 + kk) * N + n0 + (lane & 31)]; }
    asm volatile("s_waitcnt lgkmcnt(0)" ::: "memory");
    const int c = lane & 7;
#pragma unroll
    for (int j = 0; j < 4; ++j) { const int n = (lane >> 3) + 8 * j; const LAS float* s = scr + (8 * c) * 33 + n;
        v4u o; o.x = pk2(s[0 * 33], s[1 * 33]); o.y = pk2(s[2 * 33], s[3 * 33]); o.z = pk2(s[4 * 33], s[5 * 33]); o.w = pk2(s[6 * 33], s[7 * 33]);
        *(v4u*)(WT + (size_t)(drow0 + n) * K + k0 + 8 * c) = o; }
    asm volatile("s_waitcnt lgkmcnt(0)" ::: "memory");
}
__device__ __forceinline__ void p0_adaln_item(const Ctx& C, int it) {
    const int layer = it / 96, n0 = (it % 96) * 64;
    const float* W = C.in[4] + (size_t)layer * DMODEL * 6144;
    const float* cvec = C.in[1]; const float* cctx = C.in[3];
    const int cq = C.tid & 15, kp = C.tid >> 4;
    f32x4 a = {0.f, 0.f, 0.f, 0.f}, ac = {0.f, 0.f, 0.f, 0.f};
#pragma unroll 4
    for (int i = 0; i < 32; ++i) { const int k = kp * 32 + i; const float s = silu_f(cvec[k]), sc = silu_f(cctx[k]);
        const f32x4 w = *(const f32x4*)(W + (size_t)k * 6144 + n0 + 4 * cq); a += s * w; ac += sc * w; }
    LAS float* scr = (LAS float*)C.lds;
    *(LAS f32x4*)(scr + kp * 64 + 4 * cq) = a; *(LAS f32x4*)(scr + 2048 + kp * 64 + 4 * cq) = ac;
    __syncthreads();
    if (C.tid < 128) { const int which = C.tid >> 6, col = C.tid & 63; float s = 0.f;
        for (int q = 0; q < 32; ++q) s += scr[which * 2048 + q * 64 + col];
        const int n = n0 + col; const float b = C.in[5][layer * 6144 + n];
        if (which == 0) SMP(float, layer ? SM_MOD1 : SM_MOD0)[n] = s + b;
        else if (layer == 0 && n < 2048) SMP(float, SM_CMOD)[n] = s + b; }
    __syncthreads();
}
__device__ __forceinline__ void p0_prologue(const Ctx& C) {
    for (int it = C.blk; it < 192; it += C.G) p0_adaln_item(C, it);
    LAS float* scr = (LAS float*)(C.lds + C.wave * 16384);
    const int gw = C.vcu * NWAVES + C.wave, NGW = C.G * NWAVES;
    constexpr int I_IN0 = 16 * 48, I_OUT = 16 * 32, I_G0 = 16 * 88, I_D0 = 44 * 32, I_IN1 = 16 * 96, I_EG = 16 * 112, I_ED = 56 * 32;
    constexpr int NITEMS = I_IN0 + I_OUT + 2 * I_G0 + I_D0 + I_IN1 + I_OUT + 8 * (2 * I_EG + I_ED);
    for (int it = gw; it < NITEMS; it += NGW) {
        int r = it;
        if (r < I_IN0) { p0_transpose_item(C.in[7], 1024, 1536, WSP(bf16, WS_WIN0), 0, 0, scr, r, C.lane); continue; } r -= I_IN0;
        if (r < I_OUT) { p0_transpose_item(C.in[10], 1024, 1024, WSP(bf16, WS_WOUT0), 0, 0, scr, r, C.lane); continue; } r -= I_OUT;
        if (r < I_G0) { p0_transpose_item(C.in[11], 1024, DFF, WSP(bf16, WS_WGU0), 1, 0, scr, r, C.lane); continue; } r -= I_G0;
        if (r < I_G0) { p0_transpose_item(C.in[12], 1024, DFF, WSP(bf16, WS_WGU0), 1, 1, scr, r, C.lane); continue; } r -= I_G0;
        if (r < I_D0) { p0_transpose_item(C.in[13], DFF, 1024, WSP(bf16, WS_WDN0), 0, 0, scr, r, C.lane); continue; } r -= I_D0;
        if (r < I_IN1) { p0_transpose_item(C.in[14], 1024, 3072, WSP(bf16, WS_WIN1), 0, 0, scr, r, C.lane); continue; } r -= I_IN1;
        if (r < I_OUT) { p0_transpose_item(C.in[16], 1024, 1024, WSP(bf16, WS_WOUT1), 0, 0, scr, r, C.lane); continue; } r -= I_OUT;
        const int per_e = 2 * I_EG + I_ED, e = r / per_e; r -= e * per_e;
        if (r < I_EG) { p0_transpose_item(C.in[18] + (size_t)e * 1024 * DEXP, 1024, DEXP, WSP(bf16, WS_WEGU) + (size_t)e * 2 * DEXP * 1024, 1, 0, scr, r, C.lane); continue; } r -= I_EG;
        if (r < I_EG) { p0_transpose_item(C.in[19] + (size_t)e * 1024 * DEXP, 1024, DEXP, WSP(bf16, WS_WEGU) + (size_t)e * 2 * DEXP * 1024, 1, 1, scr, r, C.lane); continue; } r -= I_EG;
        p0_transpose_item(C.in[20] + (size_t)e * DEXP * 1024, DEXP, 1024, WSP(bf16, WS_WEDN) + (size_t)e * 1024 * DEXP, 0, 0, scr, r, C.lane);
    }
}

__device__ __forceinline__ void p1_modulate(const Ctx& C) {
    LAS float* V = (LAS float*)C.lds;
    const float* g = C.in[6]; const float* mod = SMP(float, SM_MOD0); const float* cmod = SMP(float, SM_CMOD);
    for (int c = C.tid; c < 1024; c += 512) { V[c] = g[c] * (1.f + mod[1024 + c]); V[1024 + c] = mod[c]; V[2048 + c] = g[c] * (1.f + cmod[1024 + c]); V[3072 + c] = cmod[c]; }
    __syncthreads();
    const int gw = C.vcu * NWAVES + C.wave, NGW = C.G * NWAVES; bf16* H = WSP(bf16, WS_H);
    for (int m = gw; m < MROWS; m += NGW) {
        const float* src = (m < SEQ) ? C.in[0] + (size_t)m * 1024 : C.in[2] + (size_t)(m - SEQ) * 1024;
        const LAS float* VA = V + ((m < SEQ) ? 0 : 2048); const LAS float* VB = VA + 1024;
        f32x4 v[4]; float ss = 0.f;
#pragma unroll
        for (int j = 0; j < 4; ++j) { v[j] = *(const f32x4*)(src + 4 * C.lane + 256 * j); ss += sum4(v[j] * v[j]); }
        const float r = __builtin_amdgcn_rsqf(wave_sum(ss) * (1.f / 1024.f) + NEPS);
#pragma unroll
        for (int j = 0; j < 4; ++j) { const int c = 4 * C.lane + 256 * j; const f32x4 a = *(const LAS f32x4*)(VA + c), b = *(const LAS f32x4*)(VB + c);
            st_bf4(H + (size_t)m * 1024 + c, v[j] * r * a + b); }
    }
    __syncthreads();
}
template <int MODE>
__device__ __forceinline__ void post_rows(const Ctx& C, const float* gt, const float* gpost, const float* gpre, const float* sc, const float* sh,
                                          const float* xsrc, const bf16* ysrc, float* xdst, bf16* hdst) {
    LAS float* V = (LAS float*)C.lds;
    LAS float* RT = V + 3072;
    LAS int* SEL = (LAS int*)(V + 3072 + 8192);
    LAS int* RNK = SEL + 128;
    for (int c = C.tid; c < 1024; c += 512) { V[c] = gt[c] * gpost[c];
        if (MODE != 3) { V[1024 + c] = gpre[c] * (1.f + sc[c]); V[2048 + c] = sh[c]; } }
    if (MODE == 2) { const float* R = C.in[17]; for (int i = C.tid; i < 8192; i += 512) { const int c = i >> 3, e = i & 7; RT[e * 1024 + c] = R[i]; } }
    __syncthreads();
    const int rows_per_blk = SEQ / C.G, rows_per_wave = rows_per_blk / NWAVES;
    for (int i = 0; i < rows_per_wave; ++i) {
        const int rl = C.wave * rows_per_wave + i, m = C.blk * rows_per_blk + rl;
        f32x4 xv[4], yv[4]; float ss = 0.f;
        if (MODE == 3) {
            const int* tp = SMP(int, SM_TOKP) + 2 * m; const float* tw = SMP(float, SM_TOKW) + 2 * m;
            const int p0 = tp[0], p1 = tp[1]; const float w0 = tw[0], w1 = tw[1];
            const bf16* y0 = WSP(bf16, WS_YP) + (size_t)p0 * 1024; const bf16* y1 = WSP(bf16, WS_YP) + (size_t)p1 * 1024;
#pragma unroll
            for (int j = 0; j < 4; ++j) { const int c = 4 * C.lane + 256 * j; yv[j] = w0 * ld_bf4(y0 + c) + w1 * ld_bf4(y1 + c); }
        } else {
#pragma unroll
            for (int j = 0; j < 4; ++j) yv[j] = ld_bf4(ysrc + (size_t)m * 1024 + 4 * C.lane + 256 * j);
        }
#pragma unroll
        for (int j = 0; j < 4; ++j) { xv[j] = *(const f32x4*)(xsrc + (size_t)m * 1024 + 4 * C.lane + 256 * j); ss += sum4(yv[j] * yv[j]); }
        const float ry = __builtin_amdgcn_rsqf(wave_sum(ss) * (1.f / 1024.f) + NEPS);
        float s1 = 0.f;
#pragma unroll
        for (int j = 0; j < 4; ++j) { const int c = 4 * C.lane + 256 * j; xv[j] += *(const LAS f32x4*)(V + c) * (yv[j] * ry); s1 += sum4(xv[j] * xv[j]);
            *(f32x4*)(xdst + (size_t)m * 1024 + c) = xv[j]; }
        if (MODE == 3) continue;
        const float r1 = __builtin_amdgcn_rsqf(wave_sum(s1) * (1.f / 1024.f) + NEPS);
        f32x4 la = {0.f, 0.f, 0.f, 0.f}, lb = {0.f, 0.f, 0.f, 0.f};
#pragma unroll
        for (int j = 0; j < 4; ++j) { const int c = 4 * C.lane + 256 * j;
            const f32x4 h = xv[j] * r1 * *(const LAS f32x4*)(V + 1024 + c) + *(const LAS f32x4*)(V + 2048 + c);
            st_bf4(hdst + (size_t)m * 1024 + c, h);
            if (MODE == 2) {
#pragma unroll
                for (int e = 0; e < 4; ++e) { la[e] += sum4(h * *(const LAS f32x4*)(RT + e * 1024 + c)); lb[e] += sum4(h * *(const LAS f32x4*)(RT + (4 + e) * 1024 + c)); }
            }
        }
        if (MODE == 2) {
#pragma unroll
            for (int e = 0; e < 4; ++e) { la[e] = wave_sum(la[e]); lb[e] = wave_sum(lb[e]); }
            int e0 = 0; float l0 = la[0];
#pragma unroll
            for (int e = 1; e < 8; ++e) { const float le = e < 4 ? la[e & 3] : lb[e & 3]; if (le > l0) { l0 = le; e0 = e; } }
            int e1 = -1; float l1 = -INFINITY;
#pragma unroll
            for (int e = 0; e < 8; ++e) { const float le = e < 4 ? la[e & 3] : lb[e & 3]; if (e != e0 && le > l1) { l1 = le; e1 = e; } }
            const float w0 = __builtin_amdgcn_rcpf(1.f + fast_exp(l1 - l0)), w1 = 1.f - w0;
            if (C.lane == 0) { int* te = SMP(int, SM_TOKE) + 2 * m; te[0] = e0; te[1] = e1; float* tw = SMP(float, SM_TOKW) + 2 * m; tw[0] = w0; tw[1] = w1;
                SEL[2 * rl] = e0; SEL[2 * rl + 1] = e1; }
        }
    }
    if (MODE == 2) {
        __syncthreads();
        if (C.tid < 8) { int cnt = 0; for (int q = 0; q < 2 * rows_per_blk; ++q) if (SEL[q] == C.tid) { RNK[q] = cnt; ++cnt; }
            SMP(int, SM_BLKCNT)[C.blk * 8 + C.tid] = cnt; }
        __syncthreads();
        if (C.tid < 2 * rows_per_blk) SMP(int, SM_TOKR)[C.blk * 2 * rows_per_blk + C.tid] = RNK[C.tid];
    }
    __syncthreads();
}

__device__ __forceinline__ void p3_qknorm_rope(const Ctx& C) {
    const int gw = C.vcu * NWAVES + C.wave, NGW = C.G * NWAVES; bf16* QK = WSP(bf16, WS_QKVF);
    const int hd = C.lane >> 2, sub = C.lane & 3; const bool isq = hd < 12;
    const float* gain = isq ? C.in[8] : C.in[9];
    f32x4 g0 = *(const f32x4*)(gain + 4 * sub), g1 = *(const f32x4*)(gain + 16 + 4 * sub), g2 = *(const f32x4*)(gain + 32 + 4 * sub), g3 = *(const f32x4*)(gain + 48 + 4 * sub);
    f32x4 invf;
#pragma unroll
    for (int e = 0; e < 4; ++e) invf[e] = __builtin_amdgcn_exp2f(-(float)(4 * sub + e) * (13.287712379549449f / 16.f));
    const float qs = isq ? (0.125f * 1.4426950408889634f) : 1.f;
    for (int m = gw; m < MROWS; m += NGW) {
        if (m >= SEQ && isq) continue;
        bf16* p = QK + (size_t)m * NQKVF + hd * 64 + 4 * sub;
        f32x4 a0 = ld_bf4(p), a1 = ld_bf4(p + 16), b0 = ld_bf4(p + 32), b1 = ld_bf4(p + 48);
        float ss = sum4(a0 * a0) + sum4(a1 * a1) + sum4(b0 * b0) + sum4(b1 * b1);
        ss += __shfl_xor(ss, 1); ss += __shfl_xor(ss, 2);
        const float r = __builtin_amdgcn_rsqf(ss * (1.f / 64.f) + NEPS) * qs;
        a0 = a0 * r * g0; a1 = a1 * r * g1; b0 = b0 * r * g2; b1 = b1 * r * g3;
        if (m < SEQ) {
            const float rp = (float)(m >> 6), cp = (float)(m & 63);
            f32x4 o0, o1, o2, o3;
#pragma unroll
            for (int e = 0; e < 4; ++e) {
                const float ar = (rp * invf[e]) * 0.15915494309189535f, ac = (cp * invf[e]) * 0.15915494309189535f;
                const float cr = __builtin_amdgcn_cosf(ar), sr = __builtin_amdgcn_sinf(ar), cc = __builtin_amdgcn_cosf(ac), sc = __builtin_amdgcn_sinf(ac);
                o0[e] = a0[e] * cr - a1[e] * sr; o1[e] = a0[e] * sr + a1[e] * cr; o2[e] = b0[e] * cc - b1[e] * sc; o3[e] = b0[e] * sc + b1[e] * cc; }
            a0 = o0; a1 = o1; b0 = o2; b1 = o3;
        }
        st_bf4(p, a0); st_bf4(p + 16, a1); st_bf4(p + 32, b0); st_bf4(p + 48, b1);
    }
}

__device__ __forceinline__ void dft128_frags(int wave, int fr, int kg, bf16x8 (&dc)[4], bf16x8 (&ds)[4]) {
#pragma unroll
    for (int ks = 0; ks < 4; ++ks)
#pragma unroll
        for (int i = 0; i < 8; ++i) { const int k = 16 * wave + fr, t = 32 * ks + 8 * kg + i; const float f = (float)((k * t) & 127) * (1.f / 128.f);
            dc[ks][i] = (short)f2bf(__builtin_amdgcn_cosf(f)); ds[ks][i] = (short)f2bf(__builtin_amdgcn_sinf(f)); }
}
__device__ __forceinline__ bf16x8 neg8(bf16x8 v) { v4u u = __builtin_bit_cast(v4u, v); u ^= 0x80008000u; return __builtin_bit_cast(bf16x8, u); }
__device__ __forceinline__ void fourier1_unit(const Ctx& C, int t2, int jh, const bf16x8 (&dc)[4], const bf16x8 (&ds)[4]) {
    LAS bf16* UT = (LAS bf16*)C.lds;
    const bf16* QK = WSP(bf16, WS_QKVF);
#pragma unroll
    for (int i = 0; i < 4; ++i) { const int ch = C.tid + 512 * i, t1 = ch >> 4, c8 = ch & 15;
        const v4u v = *(const v4u*)(QK + (size_t)(128 * t1 + t2) * NQKVF + FCOL + jh * 128 + c8 * 8);
#pragma unroll
        for (int e = 0; e < 4; ++e) { UT[(c8 * 8 + 2 * e) * 136 + t1] = (bf16)(v[e] & 0xffffu); UT[(c8 * 8 + 2 * e + 1) * 136 + t1] = (bf16)(v[e] >> 16); } }
    __syncthreads();
    const int fr = C.lane & 15, kg = C.lane >> 4;
    bf16* PB = WSP(bf16, WS_PB); bf16* QB = WSP(bf16, WS_QB);
#pragma unroll 1
    for (int nh = 0; nh < 2; ++nh) {
        f32x4 aC[4], aS[4];
#pragma unroll
        for (int nt = 0; nt < 4; ++nt) { aC[nt] = (f32x4){0.f, 0.f, 0.f, 0.f}; aS[nt] = (f32x4){0.f, 0.f, 0.f, 0.f}; }
#pragma unroll
        for (int ks = 0; ks < 4; ++ks)
#pragma unroll
            for (int nt = 0; nt < 4; ++nt) { const bf16x8 b = *(const LAS bf16x8*)(UT + (64 * nh + 16 * nt + fr) * 136 + 32 * ks + 8 * kg);
                aC[nt] = __builtin_amdgcn_mfma_f32_16x16x32_bf16(dc[ks], b, aC[nt], 0, 0, 0); aS[nt] = __builtin_amdgcn_mfma_f32_16x16x32_bf16(ds[ks], b, aS[nt], 0, 0, 0); }
#pragma unroll
        for (int rg = 0; rg < 4; ++rg) { const int k1 = 16 * C.wave + 4 * kg + rg; const float ph = (float)(k1 * t2) * (1.f / 16384.f);
            const float cp = __builtin_amdgcn_cosf(ph), sp = __builtin_amdgcn_sinf(ph); const size_t ro = ((size_t)k1 * 128 + t2) * 256 + jh * 128 + nh * 64 + fr;
#pragma unroll
            for (int nt = 0; nt < 4; ++nt) { const float sr = aC[nt][rg], ss = aS[nt][rg];
                PB[ro + 16 * nt] = (bf16)f2bf(sr * cp - ss * sp); QB[ro + 16 * nt] = (bf16)f2bf(sr * sp + ss * cp); } }
    }
    __syncthreads();
}
constexpr int F2_CT_OFF = 40960, F2_ST_OFF = 40960 + 9216;
__device__ __forceinline__ void fourier2_tables(const Ctx& C) {
    LAS bf16* CT = (LAS bf16*)(C.lds + F2_CT_OFF); LAS bf16* ST = (LAS bf16*)(C.lds + F2_ST_OFF);
    for (int i = C.tid; i < 4096; i += 512) { const int m = i >> 6, j = i & 63; const float f = (float)((m * j) & 63) * (1.f / 64.f);
        CT[m * 72 + j] = (bf16)f2bf(__builtin_amdgcn_cosf(f)); ST[m * 72 + j] = (bf16)f2bf(__builtin_amdgcn_sinf(f)); }
    __syncthreads();
}
__device__ __forceinline__ void fourier2_unit(const Ctx& C, int k1, int g, const bf16x8 (&dc)[4], const bf16x8 (&ds)[4]) {
    LAS bf16* PT = (LAS bf16*)C.lds; LAS bf16* QT = PT + 64 * 136;
    LAS bf16* XR = (LAS bf16*)C.lds; LAS bf16* XQ = XR + 128 * 72;
    const LAS bf16* CT = (const LAS bf16*)(C.lds + F2_CT_OFF); const LAS bf16* ST = (const LAS bf16*)(C.lds + F2_ST_OFF);
    const bf16* PB = WSP(bf16, WS_PB); const bf16* QB = WSP(bf16, WS_QB);
#pragma unroll
    for (int i = 0; i < 4; ++i) { const int ch = C.tid + 512 * i, mat = ch >> 10, r = ch & 1023, t2 = r >> 3, c8 = r & 7;
        const v4u v = *(const v4u*)((mat ? QB : PB) + ((size_t)k1 * 128 + t2) * 256 + g * 64 + c8 * 8); LAS bf16* dst = mat ? QT : PT;
#pragma unroll
        for (int e = 0; e < 4; ++e) { dst[(c8 * 8 + 2 * e) * 136 + t2] = (bf16)(v[e] & 0xffffu); dst[(c8 * 8 + 2 * e + 1) * 136 + t2] = (bf16)(v[e] >> 16); } }
    __syncthreads();
    const int fr = C.lane & 15, kg = C.lane >> 4;
    f32x4 xr[4], xq[4];
#pragma unroll
    for (int nt = 0; nt < 4; ++nt) { xr[nt] = (f32x4){0.f, 0.f, 0.f, 0.f}; xq[nt] = (f32x4){0.f, 0.f, 0.f, 0.f}; }
#pragma unroll
    for (int ks = 0; ks < 4; ++ks)
#pragma unroll
        for (int nt = 0; nt < 4; ++nt) { const bf16x8 bp = *(const LAS bf16x8*)(PT + (16 * nt + fr) * 136 + 32 * ks + 8 * kg), bq = *(const LAS bf16x8*)(QT + (16 * nt + fr) * 136 + 32 * ks + 8 * kg);
            xr[nt] = __builtin_amdgcn_mfma_f32_16x16x32_bf16(dc[ks], bp, xr[nt], 0, 0, 0); xr[nt] = __builtin_amdgcn_mfma_f32_16x16x32_bf16(ds[ks], neg8(bq), xr[nt], 0, 0, 0);
            xq[nt] = __builtin_amdgcn_mfma_f32_16x16x32_bf16(dc[ks], bq, xq[nt], 0, 0, 0); xq[nt] = __builtin_amdgcn_mfma_f32_16x16x32_bf16(ds[ks], bp, xq[nt], 0, 0, 0); }
    __syncthreads();
#pragma unroll
    for (int nt = 0; nt < 4; ++nt)
#pragma unroll
        for (int rg = 0; rg < 4; ++rg) { const int k2 = 16 * C.wave + 4 * kg + rg, j = 16 * nt + fr; XR[k2 * 72 + j] = (bf16)f2bf(xr[nt][rg]); XQ[k2 * 72 + j] = (bf16)f2bf(xq[nt][rg]); }
    __syncthreads();
    f32x4 o[4];
#pragma unroll
    for (int nt = 0; nt < 4; ++nt) o[nt] = (f32x4){0.f, 0.f, 0.f, 0.f};
#pragma unroll
    for (int ks = 0; ks < 2; ++ks) { const bf16x8 ar = *(const LAS bf16x8*)(XR + (16 * C.wave + fr) * 72 + 32 * ks + 8 * kg), aq = neg8(*(const LAS bf16x8*)(XQ + (16 * C.wave + fr) * 72 + 32 * ks + 8 * kg));
#pragma unroll
        for (int nt = 0; nt < 4; ++nt) { const bf16x8 bc = *(const LAS bf16x8*)(CT + (16 * nt + fr) * 72 + 32 * ks + 8 * kg), bs = *(const LAS bf16x8*)(ST + (16 * nt + fr) * 72 + 32 * ks + 8 * kg);
            o[nt] = __builtin_amdgcn_mfma_f32_16x16x32_bf16(ar, bc, o[nt], 0, 0, 0); o[nt] = __builtin_amdgcn_mfma_f32_16x16x32_bf16(aq, bs, o[nt], 0, 0, 0); } }
    bf16* MIX = WSP(bf16, WS_MIX);
#pragma unroll
    for (int nt = 0; nt < 4; ++nt)
#pragma unroll
        for (int rg = 0; rg < 4; ++rg) { const int k2 = 16 * C.wave + 4 * kg + rg; MIX[(size_t)(k1 + 128 * k2) * 1024 + 768 + 64 * g + 16 * nt + fr] = (bf16)f2bf(o[nt][rg] * (1.f / 1024.f)); }
    __syncthreads();
}

__device__ __forceinline__ void p11_conv_gate(const Ctx& C) {
    const bf16* B = WSP(bf16, WS_BCU); bf16* V = WSP(bf16, WS_VB); const float* cw = C.in[15];
    const int nthr = C.G * 512;
    for (int idx = C.blk * 512 + C.tid; idx < SEQ * 128; idx += nthr) {
        const int t = idx >> 7, c0 = (idx & 127) * 8;
        const bf16* row = B + (size_t)t * 3072 + c0;
        float cu[3][8];
#pragma unroll
        for (int d = 0; d < 3; ++d) { const int tt = t + d - 1; const bool ok = (tt >= 0) && (tt < SEQ);
            f32x4 c_lo = {0.f, 0.f, 0.f, 0.f}, c_hi = c_lo, u_lo = c_lo, u_hi = c_lo;
            if (ok) { const bf16* r2 = B + (size_t)tt * 3072 + c0; c_lo = ld_bf4(r2 + 1024); c_hi = ld_bf4(r2 + 1028); u_lo = ld_bf4(r2 + 2048); u_hi = ld_bf4(r2 + 2052); }
#pragma unroll
            for (int e = 0; e < 4; ++e) { cu[d][e] = c_lo[e] * u_lo[e]; cu[d][4 + e] = c_hi[e] * u_hi[e]; } }
        const f32x4 b_lo = ld_bf4(row), b_hi = ld_bf4(row + 4);
        f32x4 o_lo, o_hi;
#pragma unroll
        for (int e = 0; e < 4; ++e) {
            o_lo[e] = b_lo[e] * (cw[c0 + e] * cu[0][e] + cw[1024 + c0 + e] * cu[1][e] + cw[2048 + c0 + e] * cu[2][e]);
            o_hi[e] = b_hi[e] * (cw[c0 + 4 + e] * cu[0][4 + e] + cw[1024 + c0 + 4 + e] * cu[1][4 + e] + cw[2048 + c0 + 4 + e] * cu[2][4 + e]); }
        st_bf4(V + (size_t)t * 1024 + c0, o_lo); st_bf4(V + (size_t)t * 1024 + c0 + 4, o_hi);
    }
}

__device__ __forceinline__ void p14_gather(const Ctx& C) {
    LAS unsigned* T = (LAS unsigned*)C.lds;
    if (C.tid < 24) T[C.tid] = 0u;
    __syncthreads();
    const int* bc = SMP(int, SM_BLKCNT);
    for (int idx = C.tid; idx < C.G * 8; idx += 512) { const int b = idx >> 3, e = idx & 7; const unsigned v = (unsigned)bc[idx];
        atomicAdd((unsigned*)&T[e], v); if (b < C.blk) atomicAdd((unsigned*)&T[8 + e], v); }
    __syncthreads();
    if (C.tid == 0) { unsigned off = 0, tile = 0; int* te = SMP(int, SM_TILEE);
        for (int e = 0; e < 8; ++e) { T[16 + e] = off + T[8 + e]; const unsigned nt = (T[e] + 255u) >> 8;
            if (C.blk == 0) for (unsigned q = 0; q < nt; ++q) te[tile + q] = e;
            tile += nt; off += nt * 256u; }
        if (C.blk == 0) te[MOE_TILES_MAX] = (int)tile; }
    __syncthreads();
    const int rows_per_blk = SEQ / C.G, ent_per_wave = 2 * rows_per_blk / NWAVES;
    const bf16* H = WSP(bf16, WS_H); bf16* HP = WSP(bf16, WS_HPERM);
    for (int i = 0; i < ent_per_wave; ++i) { const int ent = C.wave * ent_per_wave + i, gent = C.blk * 2 * rows_per_blk + ent, m = gent >> 1;
        const int e = SMP(int, SM_TOKE)[gent], rk = SMP(int, SM_TOKR)[gent]; const int pos = (int)T[16 + e] + rk;
        const v4u* src = (const v4u*)(H + (size_t)m * 1024); v4u* dst = (v4u*)(HP + (size_t)pos * 1024);
        dst[C.lane] = src[C.lane]; dst[C.lane + 64] = src[C.lane + 64];
        if (C.lane == 0) SMP(int, SM_TOKP)[gent] = pos; }
    __syncthreads();
}

struct MoeOrder {
    pg8::StaticOrder so; int t0, bstride, a_rel; const LAS int* te;
    __device__ __forceinline__ void init(int t0_, int ntiles, int nN, int bstride_, int a_rel_, const LAS int* te_, int G, int c) {
        t0 = t0_; bstride = bstride_; a_rel = a_rel_; te = te_; so.nM = ntiles; so.nN = nN; so.nwg = ntiles * nN; so.G = G; so.c = c; }
    __device__ __forceinline__ bool next(int i, pg8::Unit& u) const {
        if (!so.next(i, u)) return false;
        const int loc = u.pm, tile = t0 + loc, e = te[tile];
        u.pb = e * bstride + u.pn;
        if (a_rel) { u.pa = loc; u.pm = tile; } else { u.pa = tile; u.pm = loc; }
        return true; }
    __device__ __forceinline__ void a_ready(const pg8::Unit&) const {}
    __device__ __forceinline__ void done(const pg8::Unit&) const {}
};

struct Args { const float* in[21]; float* out; unsigned char* ws; int ph_lo, ph_hi; };
__global__ void __launch_bounds__(NWAVES * 64, 2) mk_fwd(Args args) {
    extern __shared__ __attribute__((aligned(16))) unsigned char lds[];
    Ctx C;
    C.lds = (LAS unsigned char*)lds;
    C.tid = threadIdx.x; C.lane = C.tid & 63; C.wave = __builtin_amdgcn_readfirstlane(C.tid >> 6);
    C.G = gridDim.x; C.blk = blockIdx.x; C.vcu = (C.G % 8 == 0) ? (C.blk % 8) * (C.G / 8) + C.blk / 8 : C.blk;
#pragma unroll
    for (int i = 0; i < 21; ++i) C.in[i] = args.in[i];
    C.out = args.out; C.ws = args.ws;
    volatile LAS unsigned* LCTL = (volatile LAS unsigned*)(C.lds + LDSCTL_OFF);
    for (int u = C.tid; u < (LDS_BYTES - LDSCTL_OFF) / 4; u += NWAVES * 64) LCTL[u] = 0u;
    __syncthreads();
    const int lo = args.ph_lo, hi = args.ph_hi;
    const bool use_bar = (hi - lo) > 1;
    XcdBarrier bar; bar.bar = (unsigned*)(C.ws + WS_CTL) + CW_BAR; bar.x = 0; bar.st = LCTL;
    if (use_bar) bar = xcd_barrier_post((unsigned*)(C.ws + WS_CTL) + CW_BAR, LCTL);
#define IN(k) (lo <= (k) && (k) < hi)
#define SEAM(k) do { if (IN(k) && IN((k) + 1)) xcd_barrier(bar); } while (0)
    const float* mod0 = SMP(float, SM_MOD0); const float* mod1 = SMP(float, SM_MOD1); const float* nw = C.in[6];
    LAS unsigned char* ring = C.lds + RING_OFF;

    if (IN(0)) { p0_prologue(C); } SEAM(0);
    if (IN(1)) { p1_modulate(C); } SEAM(1);
    if (IN(2)) {
        pg8::Gemm g{WSP(bf16, WS_H), WSP(bf16, WS_WIN0), MROWS, NQKVF, 1024}; pg8::StaticOrder S; S.init(MROWS, NQKVF, C.G, C.blk);
        pg8::EpiBf16<0> E{WSP(bf16, WS_QKVF), NQKVF, nullptr, 0, 0, 1.f};
        pg8::gemm_phase<pg8::EpiBf16<0>, pg8::StaticOrder, true, true>(ring, g, S, E);
    } SEAM(2);
    if (IN(3)) {
        p3_qknorm_rope(C);
        bf16x8 dc[4], ds[4]; dft128_frags(C.wave, C.lane & 15, C.lane >> 4, dc, ds);
        for (int u = C.vcu; u < 256; u += C.G) fourier1_unit(C, u >> 1, u & 1, dc, ds);
    } SEAM(3);
    if (IN(4)) {
        { bf16x8 dc[4], ds[4]; dft128_frags(C.wave, C.lane & 15, C.lane >> 4, dc, ds);
          fourier2_tables(C);
          for (int u = C.vcu; u < 512; u += C.G) fourier2_unit(C, u >> 2, u & 3, dc, ds); }
        __syncthreads();
        const attn_body::AttnTensors AT{(const attn_body::bf16*)WSP(bf16, WS_QKVF), (const attn_body::bf16*)(WSP(bf16, WS_QKVF) + KCOL), (const attn_body::bf16*)(WSP(bf16, WS_QKVF) + VCOL), (attn_body::bf16*)WSP(bf16, WS_MIX)};
        const attn_body::GqaOrder S(C.G, C.blk);
        attn_body::attn_phase<attn_body::GqaOrder>((char*)lds + RING_OFF, AT, S);
    } SEAM(4);
    if (IN(5)) {
        pg8::Gemm g{WSP(bf16, WS_MIX), WSP(bf16, WS_WOUT0), SEQ, 1024, 1024}; pg8::StaticOrder S; S.init(SEQ, 1024, C.G, C.blk);
        pg8::EpiBf16<0> E{WSP(bf16, WS_Y), 1024, nullptr, 0, 0, 1.f};
        pg8::gemm_phase<pg8::EpiBf16<0>, pg8::StaticOrder, true, true>(ring, g, S, E);
    } SEAM(5);
    if (IN(6)) { post_rows<1>(C, mod0 + 2048, nw + 1024, nw + 2048, mod0 + 4096, mod0 + 3072, C.in[0], WSP(bf16, WS_Y), C.out, WSP(bf16, WS_H)); } SEAM(6);
    if (IN(7)) {
        pg8::Gemm g{WSP(bf16, WS_H), WSP(bf16, WS_WGU0), SEQ, 2 * DFF, 1024}; pg8::StaticOrder S; S.init(SEQ, 2 * DFF, C.G, C.blk);
        pg8::EpiSwiGLU E{WSP(bf16, WS_ACT0), DFF};
        pg8::gemm_phase<pg8::EpiSwiGLU, pg8::StaticOrder, true, true>(ring, g, S, E);
    } SEAM(7);
    if (IN(8)) {
        pg8::Gemm g{WSP(bf16, WS_ACT0), WSP(bf16, WS_WDN0), SEQ, 1024, DFF}; pg8::StaticOrder S; S.init(SEQ, 1024, C.G, C.blk);
        pg8::EpiBf16<0> E{WSP(bf16, WS_Y), 1024, nullptr, 0, 0, 1.f};
        pg8::gemm_phase<pg8::EpiBf16<0>, pg8::StaticOrder, true, true>(ring, g, S, E);
    } SEAM(8);
    if (IN(9)) { post_rows<1>(C, mod0 + 5120, nw + 3072, nw + 4096, mod1 + 1024, mod1, C.out, WSP(bf16, WS_Y), C.out, WSP(bf16, WS_H)); } SEAM(9);
    if (IN(10)) {
        pg8::Gemm g{WSP(bf16, WS_H), WSP(bf16, WS_WIN1), SEQ, 3072, 1024}; pg8::StaticOrder S; S.init(SEQ, 3072, C.G, C.blk);
        pg8::EpiBf16<0> E{WSP(bf16, WS_BCU), 3072, nullptr, 0, 0, 1.f};
        pg8::gemm_phase<pg8::EpiBf16<0>, pg8::StaticOrder, true, true>(ring, g, S, E);
    } SEAM(10);
    if (IN(11)) { p11_conv_gate(C); } SEAM(11);
    if (IN(12)) {
        pg8::Gemm g{WSP(bf16, WS_VB), WSP(bf16, WS_WOUT1), SEQ, 1024, 1024}; pg8::StaticOrder S; S.init(SEQ, 1024, C.G, C.blk);
        pg8::EpiBf16<0> E{WSP(bf16, WS_Y), 1024, nullptr, 0, 0, 1.f};
        pg8::gemm_phase<pg8::EpiBf16<0>, pg8::StaticOrder, true, true>(ring, g, S, E);
    } SEAM(12);
    if (IN(13)) { post_rows<2>(C, mod1 + 2048, nw + 4096 + 1024, nw + 4096 + 2048, mod1 + 4096, mod1 + 3072, C.out, WSP(bf16, WS_Y), C.out, WSP(bf16, WS_H)); } SEAM(13);
    if (IN(14)) { p14_gather(C); } SEAM(14);
#define MOE_PASS(PH, T0) \
    if (IN(PH)) { LAS int* te = (LAS int*)(C.lds + LDSCTL_OFF + 64); const int* teg = SMP(int, SM_TILEE); \
        for (int i = C.tid; i <= MOE_TILES_MAX; i += 512) te[i] = teg[i]; __syncthreads(); \
        const int ntl = te[MOE_TILES_MAX]; int np = ntl - (T0); np = np < 0 ? 0 : (np > MOE_PASS_TILES ? MOE_PASS_TILES : np); \
        pg8::Gemm g{WSP(bf16, WS_HPERM), WSP(bf16, WS_WEGU), 0, 2 * DEXP, 1024}; MoeOrder S; S.init((T0), np, 2 * DEXP / 256, 2 * DEXP / 256, 0, te, C.G, C.blk); \
        pg8::EpiSwiGLU E{WSP(bf16, WS_ACT1), DEXP}; \
        pg8::gemm_phase<pg8::EpiSwiGLU, MoeOrder, true, true>(ring, g, S, E); } SEAM(PH); \
    if (IN((PH) + 1)) { LAS int* te = (LAS int*)(C.lds + LDSCTL_OFF + 64); const int* teg = SMP(int, SM_TILEE); \
        for (int i = C.tid; i <= MOE_TILES_MAX; i += 512) te[i] = teg[i]; __syncthreads(); \
        const int ntl = te[MOE_TILES_MAX]; int np = ntl - (T0); np = np < 0 ? 0 : (np > MOE_PASS_TILES ? MOE_PASS_TILES : np); \
        pg8::Gemm g{WSP(bf16, WS_ACT1), WSP(bf16, WS_WEDN), 0, 1024, DEXP}; MoeOrder S; S.init((T0), np, 4, 4, 1, te, C.G, C.blk); \
        pg8::EpiBf16<0> E{WSP(bf16, WS_YP), 1024, nullptr, 0, 0, 1.f}; \
        pg8::gemm_phase<pg8::EpiBf16<0>, MoeOrder, true, true>(ring, g, S, E); } SEAM((PH) + 1);
    MOE_PASS(15, 0)
    MOE_PASS(17, MOE_PASS_TILES)
    if (IN(19)) { post_rows<3>(C, mod1 + 5120, nw + 4096 + 3072, nw, mod1, mod1, C.out, nullptr, C.out, nullptr); }
#undef IN
#undef SEAM
}

extern "C" void kernel_launch(void* const* d_in, const int* in_sizes, int n_in, void* d_out, int out_size, void* d_ws, size_t ws_size, hipStream_t stream) {
    static int grid = 0;
    if (grid == 0) {
        if (n_in != 21 || in_sizes[0] != SEQ * DMODEL || out_size != SEQ * DMODEL || ws_size < WS_END) {
            fprintf(stderr, "kernel_launch: unexpected problem (n_in %d, in0 %d, out %d, ws %zu, need %zu); nothing launched\n", n_in, n_in > 0 ? in_sizes[0] : -1, out_size, ws_size, (size_t)WS_END); grid = -1; return; }
        int dev = 0, cus = 0;
        if (hipGetDevice(&dev) != hipSuccess || hipDeviceGetAttribute(&cus, hipDeviceAttributeMultiprocessorCount, dev) != hipSuccess) { grid = -1; return; }
        if (hipFuncSetAttribute((const void*)mk_fwd, hipFuncAttributeMaxDynamicSharedMemorySize, LDS_BYTES) != hipSuccess) { fprintf(stderr, "kernel_launch: hipFuncSetAttribute failed\n"); grid = -1; return; }
        int per_cu = 0;
        if (hipOccupancyMaxActiveBlocksPerMultiprocessor(&per_cu, (const void*)mk_fwd, NWAVES * 64, LDS_BYTES) != hipSuccess || per_cu < 1) fprintf(stderr, "kernel_launch: occupancy query reports %d\n", per_cu);
        (void)hipGetLastError();
        if (cus != 256) { fprintf(stderr, "kernel_launch: built for 256 CUs, device has %d; nothing launched\n", cus); grid = -1; return; }
        grid = cus;
    }
    if (grid < 0) return;
    if (hipMemsetAsync((char*)d_ws + WS_CTL, 0, CTL_ZERO_BYTES, stream) != hipSuccess) return;
    Args a{};
    for (int i = 0; i < 21; ++i) a.in[i] = (const float*)d_in[i];
    a.out = (float*)d_out; a.ws = (unsigned char*)d_ws;
#if MK_N_LAUNCHES == 1
    a.ph_lo = 0; a.ph_hi = NPH;
    hipLaunchKernelGGL(mk_fwd, dim3(grid), dim3(NWAVES * 64), LDS_BYTES, stream, a);
#else
    for (int li = 0; li < NPH; ++li) { a.ph_lo = li; a.ph_hi = li + 1; hipLaunchKernelGGL(mk_fwd, dim3(grid), dim3(NWAVES * 64), LDS_BYTES, stream, a); }
#endif
}
```

```cpp
#include <hip/hip_runtime.h>
#include <cstdio>
#include <cstdint>
namespace pg8 {
#define PG8_LAS __attribute__((address_space(3)))
typedef unsigned short bf16_t;
typedef short bf16x8 __attribute__((ext_vector_type(8)));
typedef float f32x4 __attribute__((ext_vector_type(4)));
typedef unsigned u32x4 __attribute__((ext_vector_type(4)));
constexpr int BM = 256, BK = 64, HALF = 128, HTB = HALF * BK * 2  , STAGE_BYTES = 8 * HTB, NXCD = 8, WGM = 8;

__host__ __device__ __forceinline__ int lds_byte(int r, int c) { const int st = (r >> 4) * 2 + (c >> 5), rr = r & 15, cc = c & 31, ob = rr * 64 + cc * 2; return st * 1024 + (ob ^ (((ob >> 9) & 1) << 5)); }
__host__ __device__ __forceinline__ void stage_rc(int b, int& R, int& C) { const int st = b / 1024, sb = b % 1024, swz = sb ^ (((sb >> 9) & 1) << 5); R = (st >> 1) * 16 + swz / 64; C = (st & 1) * 32 + (swz % 64) / 2; }
__host__ __device__ __forceinline__ int perm32(int rho) { const int n = rho >> 4, i = rho & 15; return 8 * (i >> 2) + 4 * n + (i & 3); }

struct Unit { int pm, pn, pa, pb; };
struct Gemm { const bf16_t* A; const bf16_t* Bt; int M, N, K; };

struct StaticOrder {
    int nM, nN, nwg, G, c;
    __host__ __device__ void init(int M, int N, int G_, int c_) { nM = M / BM; nN = N / BM; nwg = nM * nN; G = G_; c = c_; }
    __host__ __device__ bool next(int i, Unit& u) const {
        const long L = (long)i * G + c; if (L >= nwg) return false;
        int wgid = (int)L; { const int q = nwg / NXCD, r = nwg % NXCD, xcd = wgid % NXCD, off = wgid / NXCD; wgid = (xcd < r ? xcd * (q + 1) : r * (q + 1) + (xcd - r) * q) + off; }
        const int nig = WGM * nN, gid = wgid / nig, fm = gid * WGM, gsz = (nM - fm) < WGM ? (nM - fm) : WGM;
        u.pm = fm + ((wgid % nig) % gsz); u.pn = (wgid % nig) / gsz; u.pa = u.pm; u.pb = u.pn; return true;
    }
    __device__ __forceinline__ void a_ready(const Unit&) const {}
    __device__ __forceinline__ void done(const Unit&) const {}
};

__device__ __forceinline__ unsigned cvt_pk_bf16(float lo, float hi) { unsigned r; asm volatile("v_cvt_pk_bf16_f32 %0, %1, %2" : "=v"(r) : "v"(lo), "v"(hi)); return r; }
typedef float f32x2 __attribute__((ext_vector_type(2)));
__device__ __forceinline__ f32x2 gelu_pk(f32x2 v) {
    const f32x2 av = __builtin_elementwise_abs(v), d = av * 0.2316418882f + 1.0f;
    f32x2 t; t.x = __builtin_amdgcn_rcpf(d.x); t.y = __builtin_amdgcn_rcpf(d.y);
    f32x2 q = t * 0.5307027145f + (-0.7265760135f); q = q * t + 0.7107068705f; q = q * t + (-0.142248368f); q = q * t + 0.127414796f; q = q * t;
    const f32x2 s = (v * v) * (-0.72134752044f);
    f32x2 e; e.x = __builtin_amdgcn_exp2f(s.x); e.y = __builtin_amdgcn_exp2f(s.y);
    const f32x2 m = v * (q * e), r = v - m;
    f32x2 o; o.x = v.x < 0.f ? m.x : r.x; o.y = v.y < 0.f ? m.y : r.y; return o;
}

template <int ACT  > struct EpiBf16 {
    static constexpr bool PERM = true, AFTER_DRAIN = false; static_assert(ACT == 0 || ACT == 1, "EpiBf16: ACT is 0 (none) or 1 (gelu_pk)");
    bf16_t* O; int ldc; const float* bias; int split_cols; size_t split_stride; float scale0;
    __device__ __forceinline__ void operator()(const f32x4 (&acc)[2][2][4][2], const Unit& u, int wr, int wc, int fr, int fq) const {
        const int row0 = u.pm * BM + wr * 64 + fr; int colt = u.pn * BM; bf16_t* base = O;
        float sc = 1.f; if (split_cols) { const int t = colt / split_cols; base += (size_t)t * split_stride; colt -= t * split_cols; if (t == 0) sc = scale0; }
        const int col0 = colt + wc * 32 + 8 * fq, bcol0 = u.pn * BM + wc * 32 + 8 * fq;
        f32x4 bv[2][2];
#pragma unroll
        for (int bj = 0; bj < 2; ++bj)
#pragma unroll
            for (int n = 0; n < 2; ++n) bv[bj][n] = bias ? *(const f32x4*)(bias + bcol0 + bj * HALF + 4 * n) : (f32x4){0.f, 0.f, 0.f, 0.f};
#pragma unroll
        for (int ai = 0; ai < 2; ++ai)
#pragma unroll
            for (int m = 0; m < 4; ++m) { bf16_t* rowp = base + (size_t)(row0 + ai * HALF + m * 16) * ldc + col0;
#pragma unroll
                for (int bj = 0; bj < 2; ++bj) { f32x4 v0 = acc[ai][bj][m][0] + bv[bj][0], v1 = acc[ai][bj][m][1] + bv[bj][1];
                    if (ACT == 1) { f32x2 a = gelu_pk((f32x2){v0[0], v0[1]}), b = gelu_pk((f32x2){v0[2], v0[3]}), c = gelu_pk((f32x2){v1[0], v1[1]}), d = gelu_pk((f32x2){v1[2], v1[3]});
                        v0 = (f32x4){a.x, a.y, b.x, b.y}; v1 = (f32x4){c.x, c.y, d.x, d.y}; }
                    v0 = v0 * sc; v1 = v1 * sc; u32x4 w; w.x = cvt_pk_bf16(v0[0], v0[1]); w.y = cvt_pk_bf16(v0[2], v0[3]); w.z = cvt_pk_bf16(v1[0], v1[1]); w.w = cvt_pk_bf16(v1[2], v1[3]);
                    *(u32x4*)(rowp + bj * HALF) = w; } }
    }
};

typedef int v8i_t __attribute__((ext_vector_type(8))); typedef int v4i_t __attribute__((ext_vector_type(4)));
__device__ __forceinline__ v8i_t cat8(bf16x8 lo, bf16x8 hi) { const v4i_t a = __builtin_bit_cast(v4i_t, lo), b = __builtin_bit_cast(v4i_t, hi); return __builtin_shufflevector(a, b, 0, 1, 2, 3, 4, 5, 6, 7); }
__device__ __forceinline__ void mfma_f8(f32x4& acc, const v8i_t& a, const v8i_t& b) { asm volatile("v_mfma_f32_16x16x128_f8f6f4 %0, %1, %2, %0" : "+v"(acc) : "v"(a), "v"(b)); }
__device__ __forceinline__ float clamp448(float x) { return __builtin_fminf(__builtin_fmaxf(x, -448.f), 448.f); }
struct EpiSwiGLU8 {
    static constexpr bool PERM = true, AFTER_DRAIN = false;
    unsigned char* O; int ldc; float ds;
    __device__ __forceinline__ void operator()(const f32x4 (&acc)[2][2][4][2], const Unit& u, int wr, int wc, int fr, int fq) const {
        const int row0 = u.pm * BM + wr * 64 + fr; const int col0 = u.pn * HALF + wc * 32 + 8 * fq;
#pragma unroll
        for (int ai = 0; ai < 2; ++ai)
#pragma unroll
            for (int m = 0; m < 4; ++m) { unsigned char* rowp = O + (size_t)(row0 + ai * HALF + m * 16) * ldc + col0;
                const f32x4 g0 = acc[ai][0][m][0] * ds, g1 = acc[ai][0][m][1] * ds, u0 = acc[ai][1][m][0] * ds, u1 = acc[ai][1][m][1] * ds;
                f32x4 r0, r1;
#pragma unroll
                for (int e = 0; e < 4; ++e) {
                    r0[e] = clamp448(g0[e] * __builtin_amdgcn_rcpf(1.0f + __builtin_amdgcn_exp2f(-1.4426950408889634f * g0[e])) * u0[e]);
                    r1[e] = clamp448(g1[e] * __builtin_amdgcn_rcpf(1.0f + __builtin_amdgcn_exp2f(-1.4426950408889634f * g1[e])) * u1[e]); }
                int w0 = 0, w1 = 0;
                w0 = __builtin_amdgcn_cvt_pk_fp8_f32(r0[0], r0[1], w0, false); w0 = __builtin_amdgcn_cvt_pk_fp8_f32(r0[2], r0[3], w0, true);
                w1 = __builtin_amdgcn_cvt_pk_fp8_f32(r1[0], r1[1], w1, false); w1 = __builtin_amdgcn_cvt_pk_fp8_f32(r1[2], r1[3], w1, true);
                typedef int v2i_t __attribute__((ext_vector_type(2))); *(v2i_t*)rowp = (v2i_t){w0, w1}; }
    }
};

struct EpiSwiGLU {
    static constexpr bool PERM = true, AFTER_DRAIN = false;
    bf16_t* O; int ldc;
    __device__ __forceinline__ void operator()(const f32x4 (&acc)[2][2][4][2], const Unit& u, int wr, int wc, int fr, int fq) const {
        const int row0 = u.pm * BM + wr * 64 + fr; const int col0 = u.pn * HALF + wc * 32 + 8 * fq;
#pragma unroll
        for (int ai = 0; ai < 2; ++ai)
#pragma unroll
            for (int m = 0; m < 4; ++m) { bf16_t* rowp = O + (size_t)(row0 + ai * HALF + m * 16) * ldc + col0;
                const f32x4 g0 = acc[ai][0][m][0], g1 = acc[ai][0][m][1], u0 = acc[ai][1][m][0], u1 = acc[ai][1][m][1];
                f32x4 r0, r1;
#pragma unroll
                for (int e = 0; e < 4; ++e) {
                    r0[e] = g0[e] * __builtin_amdgcn_rcpf(1.0f + __builtin_amdgcn_exp2f(-1.4426950408889634f * g0[e])) * u0[e];
                    r1[e] = g1[e] * __builtin_amdgcn_rcpf(1.0f + __builtin_amdgcn_exp2f(-1.4426950408889634f * g1[e])) * u1[e]; }
                u32x4 w; w.x = cvt_pk_bf16(r0[0], r0[1]); w.y = cvt_pk_bf16(r0[2], r0[3]); w.z = cvt_pk_bf16(r1[0], r1[1]); w.w = cvt_pk_bf16(r1[2], r1[3]);
                *(u32x4*)rowp = w; }
    }
};

template <class Epi, class Sched, bool ALIGN_EPI = false, bool SP2 = false, bool F8 = false>
__device__ __forceinline__ void gemm_phase(PG8_LAS unsigned char* lds, const Gemm g, const Sched& S, const Epi& E) {
    const int tid = threadIdx.x, wid = __builtin_amdgcn_readfirstlane(tid >> 6), lane = tid & 63, wr = wid >> 2, wc = wid & 3, fr = lane & 15, fq = lane >> 4;
    const int K = g.K, nt = K / BK;
    unsigned voffA[2], voffB[2];
#pragma unroll
    for (int i = 0; i < 2; ++i) { int R, C; stage_rc(tid * 16 + i * 8192, R, C); const int Rb = Epi::PERM ? ((R & ~31) + perm32(R & 31)) : R;
        voffA[i] = (unsigned)(R * K + C) * 2u; voffB[i] = (unsigned)(Rb * K + C) * 2u; }
    const size_t kstep = (size_t)(BK * 2);
    const size_t hstep = (size_t)HALF * K * 2;
    const size_t tstep = 2 * hstep;
    const unsigned ldsw = (unsigned)wid * 1024u;
    const int aoff = lds_byte(wr * 64 + fr, fq * 8), boff = lds_byte(wc * 32 + fr, fq * 8);
#define PG8_SA(b, h) (((b) * 2 + (h)) * HTB)
#define PG8_SB(b, h) ((4 + (b) * 2 + (h)) * HTB)
#define PG8_STAGE(bufoff, gbase, voff) do { _Pragma("unroll") for (int _i = 0; _i < 2; ++_i) \
        __builtin_amdgcn_global_load_lds((const unsigned*)((const char*)(gbase) + (voff)[_i]), (PG8_LAS unsigned*)(lds + (bufoff) + ldsw + _i * 8192), 16, 0, 0); } while (0)
#define PG8_LDA(dst, b, h) do { if constexpr (F8) { _Pragma("unroll") for (int m = 0; m < 4; ++m) { dst##8[m].lo = *(const PG8_LAS v4i_t*)(lds + PG8_SA(b, h) + aoff + m * 2048); dst##8[m].hi = *(const PG8_LAS v4i_t*)(lds + PG8_SA(b, h) + aoff + m * 2048 + 1024); } } \
        else { _Pragma("unroll") for (int m = 0; m < 4; ++m) _Pragma("unroll") for (int k = 0; k < 2; ++k) dst[m][k] = *(const PG8_LAS bf16x8*)(lds + PG8_SA(b, h) + aoff + m * 2048 + k * 1024); } } while (0)
#define PG8_LDB(dst, b, h) do { if constexpr (F8) { _Pragma("unroll") for (int n = 0; n < 2; ++n) { dst##8[n].lo = *(const PG8_LAS v4i_t*)(lds + PG8_SB(b, h) + boff + n * 2048); dst##8[n].hi = *(const PG8_LAS v4i_t*)(lds + PG8_SB(b, h) + boff + n * 2048 + 1024); } } \
        else { _Pragma("unroll") for (int n = 0; n < 2; ++n) _Pragma("unroll") for (int k = 0; k < 2; ++k) dst[n][k] = *(const PG8_LAS bf16x8*)(lds + PG8_SB(b, h) + boff + n * 2048 + k * 1024); } } while (0)
#define PG8_MMA(ai, bj, At, Bt) do { __builtin_amdgcn_s_setprio(1); _Pragma("unroll") for (int m = 0; m < 4; ++m) _Pragma("unroll") for (int n = 0; n < 2; ++n) { \
        if constexpr (F8) mfma_f8(acc[ai][bj][m][n], Bt##8[n], At##8[m]); \
        else { _Pragma("unroll") for (int k = 0; k < 2; ++k) acc[ai][bj][m][n] = __builtin_amdgcn_mfma_f32_16x16x32_bf16(Bt[n][k], At[m][k], acc[ai][bj][m][n], 0, 0, 0); } } __builtin_amdgcn_s_setprio(0); } while (0)
#define PG8_WAIT_V(n) asm volatile("s_waitcnt vmcnt(" #n ")" ::: "memory")
#define PG8_WAIT_L(n) asm volatile("s_waitcnt lgkmcnt(" #n ")" ::: "memory")
#define PG8_BAR __builtin_amdgcn_s_barrier()
#define PG8_SCHED __builtin_amdgcn_sched_barrier(0)
    Unit cur, nxt; int ui = 0;
    if (!S.next(0, cur)) return;
    f32x4 acc[2][2][4][2];
#pragma unroll
    for (int a = 0; a < 2; ++a)
#pragma unroll
        for (int b = 0; b < 2; ++b)
#pragma unroll
            for (int m = 0; m < 4; ++m)
#pragma unroll
                for (int n = 0; n < 2; ++n) acc[a][b][m][n] = (f32x4){0.f, 0.f, 0.f, 0.f};
    bf16x8 At[4][2], B0[2][2], B1[2][2]; v8i_t At8[4], B08[2], B18[2];
    const char* cA = (const char*)g.A + (size_t)cur.pa * tstep; const char* cB = (const char*)g.Bt + (size_t)cur.pb * tstep;
    S.a_ready(cur);
    if constexpr (SP2) {
        PG8_STAGE(PG8_SB(0, 0), cB, voffB); PG8_STAGE(PG8_SB(0, 1), cB + hstep, voffB); PG8_STAGE(PG8_SA(0, 0), cA, voffA); PG8_STAGE(PG8_SA(0, 1), cA + hstep, voffA);
        if (wr == 1) PG8_BAR;
        PG8_WAIT_V(2); PG8_BAR;
        PG8_STAGE(PG8_SB(1, 0), cB + kstep, voffB); PG8_STAGE(PG8_SA(1, 0), cA + kstep, voffA); PG8_STAGE(PG8_SB(1, 1), cB + hstep + kstep, voffB);
        PG8_WAIT_V(6); PG8_BAR;
    } else {
        PG8_STAGE(PG8_SB(0, 0), cB, voffB); PG8_STAGE(PG8_SA(0, 0), cA, voffA); PG8_STAGE(PG8_SB(0, 1), cB + hstep, voffB); PG8_STAGE(PG8_SA(0, 1), cA + hstep, voffA);
        if (wr == 1) PG8_BAR;
        PG8_WAIT_V(4); PG8_BAR;
        PG8_STAGE(PG8_SB(1, 0), cB + kstep, voffB); PG8_STAGE(PG8_SA(1, 0), cA + kstep, voffA); PG8_STAGE(PG8_SB(1, 1), cB + hstep + kstep, voffB);
        PG8_WAIT_V(6); PG8_BAR;
    }
    for (;;) {
        const bool has_next = S.next(ui + 1, nxt);
        const char* nA = has_next ? (const char*)g.A + (size_t)nxt.pa * tstep : cA; const char* nB = has_next ? (const char*)g.Bt + (size_t)nxt.pb * tstep : cB;
        for (int t = 0; t < nt; t += 2) {
            const bool last = (t == nt - 2);
            const char* a1 = cA + (size_t)(t + 1) * kstep;
            const char* a2 = last ? nA : cA + (size_t)(t + 2) * kstep; const char* b2 = last ? nB : cB + (size_t)(t + 2) * kstep;
            const char* a3 = a2 + kstep; const char* b3 = b2 + kstep;
            if (last && has_next) S.a_ready(nxt);
            if constexpr (SP2) {
            PG8_LDB(B0, 0, 0); PG8_LDB(B1, 0, 1); PG8_SCHED; PG8_LDA(At, 0, 0); PG8_STAGE(PG8_SA(1, 1), a1 + hstep, voffA);
            PG8_WAIT_V(8); PG8_WAIT_L(0); PG8_BAR; PG8_MMA(0, 0, At, B0); PG8_MMA(0, 1, At, B1); PG8_BAR; PG8_SCHED;
            PG8_LDA(At, 0, 1); PG8_STAGE(PG8_SB(0, 0), b2, voffB); PG8_STAGE(PG8_SB(0, 1), b2 + hstep, voffB); PG8_STAGE(PG8_SA(0, 0), a2, voffA);
            PG8_WAIT_V(8); PG8_WAIT_L(0); PG8_BAR; PG8_MMA(1, 0, At, B0); PG8_MMA(1, 1, At, B1); PG8_BAR; PG8_SCHED;
            PG8_LDB(B0, 1, 0); PG8_LDB(B1, 1, 1); PG8_SCHED; PG8_LDA(At, 1, 0); PG8_STAGE(PG8_SA(0, 1), a2 + hstep, voffA);
            PG8_WAIT_V(8); PG8_WAIT_L(0); PG8_BAR; PG8_MMA(0, 0, At, B0); PG8_MMA(0, 1, At, B1); PG8_BAR; PG8_SCHED;
            PG8_LDA(At, 1, 1); PG8_STAGE(PG8_SB(1, 0), b3, voffB); PG8_STAGE(PG8_SB(1, 1), b3 + hstep, voffB); PG8_STAGE(PG8_SA(1, 0), a3, voffA);
            PG8_WAIT_V(8); PG8_WAIT_L(0); PG8_BAR; PG8_MMA(1, 0, At, B0); PG8_MMA(1, 1, At, B1); PG8_BAR; PG8_SCHED;
            } else {
            PG8_LDB(B0, 0, 0); PG8_SCHED; PG8_LDA(At, 0, 0); PG8_STAGE(PG8_SA(1, 1), a1 + hstep, voffA);
            PG8_WAIT_L(8); PG8_BAR; PG8_WAIT_L(0); PG8_MMA(0, 0, At, B0); PG8_BAR; PG8_SCHED;
            PG8_LDB(B1, 0, 1); PG8_STAGE(PG8_SB(0, 0), b2, voffB);
            PG8_BAR; PG8_WAIT_L(0); PG8_MMA(0, 1, At, B1); PG8_BAR;
            PG8_LDA(At, 0, 1); PG8_STAGE(PG8_SA(0, 0), a2, voffA);
            PG8_BAR; PG8_WAIT_L(0); PG8_MMA(1, 0, At, B0); PG8_BAR; PG8_SCHED;
            PG8_STAGE(PG8_SB(0, 1), b2 + hstep, voffB);
            PG8_WAIT_V(6); PG8_BAR; PG8_MMA(1, 1, At, B1); PG8_BAR;
            PG8_LDB(B0, 1, 0); PG8_SCHED; PG8_LDA(At, 1, 0); PG8_STAGE(PG8_SA(0, 1), a2 + hstep, voffA);
            PG8_WAIT_L(8); PG8_BAR; PG8_WAIT_L(0); PG8_MMA(0, 0, At, B0); PG8_BAR; PG8_SCHED;
            PG8_LDB(B1, 1, 1); PG8_STAGE(PG8_SB(1, 0), b3, voffB);
            PG8_BAR; PG8_WAIT_L(0); PG8_MMA(0, 1, At, B1); PG8_BAR;
            PG8_LDA(At, 1, 1); PG8_STAGE(PG8_SA(1, 0), a3, voffA);
            PG8_BAR; PG8_WAIT_L(0); PG8_MMA(1, 0, At, B0); PG8_BAR; PG8_SCHED;
            PG8_STAGE(PG8_SB(1, 1), b3 + hstep, voffB);
            PG8_WAIT_V(6); PG8_BAR; PG8_MMA(1, 1, At, B1); PG8_BAR;
            }
        }
        if constexpr (ALIGN_EPI) { if (wr == 0) PG8_BAR; }
        if constexpr (F8) asm volatile("s_nop 15\n\ts_nop 15" ::: "memory");
        if constexpr (!Epi::AFTER_DRAIN) { E(acc, cur, wr, wc, fr, fq); S.done(cur); }
        if (!has_next) break;
#pragma unroll
        for (int a = 0; a < 2; ++a)
#pragma unroll
            for (int b = 0; b < 2; ++b)
#pragma unroll
                for (int m = 0; m < 4; ++m)
#pragma unroll
                    for (int n = 0; n < 2; ++n) acc[a][b][m][n] = (f32x4){0.f, 0.f, 0.f, 0.f};
        cur = nxt; cA = nA; cB = nB; ++ui;
        if constexpr (ALIGN_EPI) { if (wr == 1) PG8_BAR; }
    }
    PG8_WAIT_V(0);
    if constexpr (!ALIGN_EPI) { if (wr == 0) PG8_BAR; }
    PG8_BAR;
    if constexpr (Epi::AFTER_DRAIN) { E.fused(acc, cur, wr, wc, fr, fq, lds, wid, lane); S.done(cur); }
#undef PG8_SA
#undef PG8_SB
#undef PG8_STAGE
#undef PG8_LDA
#undef PG8_LDB
#undef PG8_MMA
#undef PG8_WAIT_V
#undef PG8_WAIT_L
#undef PG8_BAR
#undef PG8_SCHED
}
}

#include <hip/hip_bf16.h>
#include <cmath>
namespace attn_body {
using bf16=__hip_bfloat16;
using bf16x8=__attribute__((ext_vector_type(8)))short;
using s16x4=__attribute__((ext_vector_type(4)))short;
using f32x16=__attribute__((ext_vector_type(16)))float;
using u32x4=__attribute__((ext_vector_type(4)))unsigned;
constexpr int D=64,QP=1536,KP=1536,OP=1024,NKEYS=16640;
constexpr int NW=8,QBLK=32,QB=QBLK*NW,KVBLK=64;
constexpr int ATTN_UNIT_ROWS=QB;
__device__ __forceinline__ int crow(int r,int hi){return (r&3)+8*(r>>2)+4*hi;}
#define SBAR() __builtin_amdgcn_sched_barrier(0)
__device__ __forceinline__ void cmask(f32x16&p0,f32x16&p1,int jb,int qrel,int hi){
  const float NEG=-INFINITY; int kb=64*jb+4*hi;
  #pragma unroll
  for(int r=0;r<16;++r){int kv=kb+(r&3)+8*(r>>2); if(kv>qrel)p0[r]=NEG; if(kv+32>qrel)p1[r]=NEG;}
}

constexpr int NSLOT=3, SLOTB=8192;
constexpr int LDS_K=0, LDS_V=NSLOT*SLOTB, LDS_WS=2*NSLOT*SLOTB, LDS_OST=LDS_WS+NW*64*4, LDS_BYTES=LDS_OST+NW*4096;
constexpr float C2=0.125f*1.4426950408889634f;
__device__ __forceinline__ void glds16(const void*gsrc,unsigned lds_dst){unsigned keep;
  asm volatile("s_mov_b32 %0, m0\n\ts_mov_b32 m0, %2\n\ts_nop 0\n\tglobal_load_lds_dwordx4 %1, off\n\ts_mov_b32 m0, %0":"=&s"(keep):"v"(gsrc),"s"(lds_dst):"memory");}
__device__ __forceinline__ float max3f(float a,float b,float c){float r;asm("v_max3_f32 %0, %1, %2, %3":"=v"(r):"v"(a),"v"(b),"v"(c));return r;}
__device__ __forceinline__ float max2f(float a,float b){float r;asm("v_max_f32_e32 %0, %1, %2":"=v"(r):"v"(a),"v"(b));return r;}
__device__ __forceinline__ float fadd_s(float a,float b){float r;asm("v_add_f32_e32 %0, %1, %2":"=v"(r):"v"(a),"v"(b));return r;}
__device__ __forceinline__ float fsub_s(float a,float b){float r;asm("v_sub_f32_e32 %0, %1, %2":"=v"(r):"v"(a),"v"(b));return r;}
typedef float f32x2_t __attribute__((ext_vector_type(2))); typedef __bf16 bf16x2_t __attribute__((ext_vector_type(2)));
__device__ __forceinline__ unsigned cvtpk_s(float lo,float hi){f32x2_t v={lo,hi};bf16x2_t b=__builtin_convertvector(v,bf16x2_t);return __builtin_bit_cast(unsigned,b);}
#define WAIT_BAR(N) asm volatile("s_waitcnt vmcnt(" #N ") lgkmcnt(0)\n\ts_barrier":::"memory")

__device__ __forceinline__ void qkt(f32x16&p0,f32x16&p1,const char*Kslot,const bf16x8*qr,const f32x16&negm,int r32,int hi){
  const char*kb=Kslot+hi*1024+r32*16;
  #pragma unroll
  for(int d0=0;d0<4;++d0){
    const bf16x8 b0=*reinterpret_cast<const bf16x8*>(kb+d0*2048);
    const bf16x8 b1=*reinterpret_cast<const bf16x8*>(kb+d0*2048+512);
    if(d0==0){p0=__builtin_amdgcn_mfma_f32_32x32x16_bf16(b0,qr[0],negm,0,0,0);p1=__builtin_amdgcn_mfma_f32_32x32x16_bf16(b1,qr[0],negm,0,0,0);}
    else{p0=__builtin_amdgcn_mfma_f32_32x32x16_bf16(b0,qr[d0],p0,0,0,0);p1=__builtin_amdgcn_mfma_f32_32x32x16_bf16(b1,qr[d0],p1,0,0,0);}}
}
typedef __attribute__((address_space(3))) const char* lds_cptr;
typedef short v4i16_t __attribute__((ext_vector_type(4)));
__device__ __forceinline__ void kload8(bf16x8*kf,lds_cptr kp){
  kf[0]=*(const __attribute__((address_space(3))) bf16x8*)(kp);      kf[1]=*(const __attribute__((address_space(3))) bf16x8*)(kp+512);
  kf[2]=*(const __attribute__((address_space(3))) bf16x8*)(kp+2048); kf[3]=*(const __attribute__((address_space(3))) bf16x8*)(kp+2560);
  kf[4]=*(const __attribute__((address_space(3))) bf16x8*)(kp+4096); kf[5]=*(const __attribute__((address_space(3))) bf16x8*)(kp+4608);
  kf[6]=*(const __attribute__((address_space(3))) bf16x8*)(kp+6144); kf[7]=*(const __attribute__((address_space(3))) bf16x8*)(kp+6656);
}
__device__ __forceinline__ void kload2(bf16x8*kf,lds_cptr kp,int j){ kf[2*j]=*(const __attribute__((address_space(3))) bf16x8*)(kp+j*2048); kf[2*j+1]=*(const __attribute__((address_space(3))) bf16x8*)(kp+j*2048+512); }
__device__ __forceinline__ s16x4 vtr(lds_cptr p){ return __builtin_bit_cast(s16x4,__builtin_amdgcn_ds_read_tr16_b64_v4i16((__attribute__((address_space(3))) v4i16_t*)p)); }
__device__ __forceinline__ float rowmax(const f32x16&p0,const f32x16&p1){
  float a=max3f(p0[0],p0[1],p1[0]),b=max3f(p0[2],p0[3],p1[1]);a=max3f(a,p1[2],p1[3]);
  #pragma unroll
  for(int r=4;r<16;r+=4){a=max3f(a,p0[r],p0[r+1]);b=max3f(b,p0[r+2],p0[r+3]);a=max3f(a,p1[r],p1[r+1]);b=max3f(b,p1[r+2],p1[r+3]);}
  const float m=max2f(a,b);
  auto rr=__builtin_amdgcn_permlane32_swap(__float_as_uint(m),__float_as_uint(m),false,false);
  return max2f(__uint_as_float(rr[0]),__uint_as_float(rr[1]));
}
__device__ __forceinline__ void pv(f32x16*o,int vb,bf16x8 pa0,bf16x8 pa1,bf16x8 pa2,bf16x8 pa3){
  #pragma unroll
  for(int d0=0;d0<2;++d0){s16x4 lo[4],hi[4];
    #pragma unroll
    for(int ks=0;ks<4;++ks){
      asm volatile("ds_read_b64_tr_b16 %0,%1 offset:%c2":"=&v"(lo[ks]):"v"(vb),"i"(d0*4096+ks*1024):"memory");
      asm volatile("ds_read_b64_tr_b16 %0,%1 offset:%c2":"=&v"(hi[ks]):"v"(vb),"i"(d0*4096+ks*1024+512):"memory");}
    asm volatile("s_waitcnt lgkmcnt(0)":::"memory");SBAR();
    #define PK(k) (bf16x8){lo[k][0],lo[k][1],lo[k][2],lo[k][3],hi[k][0],hi[k][1],hi[k][2],hi[k][3]}
    o[d0]=__builtin_amdgcn_mfma_f32_32x32x16_bf16(pa0,PK(0),o[d0],0,0,0);
    o[d0]=__builtin_amdgcn_mfma_f32_32x32x16_bf16(pa1,PK(1),o[d0],0,0,0);
    o[d0]=__builtin_amdgcn_mfma_f32_32x32x16_bf16(pa2,PK(2),o[d0],0,0,0);
    o[d0]=__builtin_amdgcn_mfma_f32_32x32x16_bf16(pa3,PK(3),o[d0],0,0,0);
    #undef PK
  }
}

#ifndef ATTN_STORE16
#define ATTN_STORE16(p,v) (*(u32x4*)(p)=(v))
#endif
template<int THRL> __device__ __forceinline__ void attn_unit(int hq,int kvh,int qb,const bf16*Q,const bf16*__restrict__ K,const bf16*__restrict__ V,bf16*O,char*shm){
  const int tid=threadIdx.x,lane=tid&63,r32=lane&31,hi=lane>>5; const int wid=__builtin_amdgcn_readfirstlane(tid>>6);
  const int q0=qb*QB;
  const bf16*Qw=Q+(long)(q0+wid*QBLK)*QP+hq*D;
  const bf16*Kh=K+kvh*D,*Vh=V+kvh*D;
  const unsigned lds0=(unsigned)(uintptr_t)shm;
  float*wsf=(float*)(shm+LDS_WS)+wid*64;
  const bf16*ksrc=Kh+(long)lane*KP+wid*8;
  const bf16*vsrc=Vh+(long)(16*(wid&3)+(lane>>2))*KP+(wid>>2)*32+(lane&3)*8;
  const unsigned kdst=lds0+LDS_K+wid*1024, vdst=lds0+LDS_V+wid*1024;
  #define DMA_K(t,slot) glds16(ksrc+(long)(t)*KVBLK*KP,(unsigned)__builtin_amdgcn_readfirstlane(kdst+(slot)))
  #define DMA_V(t,slot) glds16(vsrc+(long)(t)*KVBLK*KP,(unsigned)__builtin_amdgcn_readfirstlane(vdst+(slot)))
  const int vb0=(int)(lds0+LDS_V)+((lane>>4)&1)*32+(lane&3)*8+(4*hi+((lane&15)>>2))*64;
  const char*Kbase=shm+LDS_K; bf16x8 kf[8];
  const lds_cptr shm3=(lds_cptr)shm; const lds_cptr kp0=shm3+LDS_K+hi*1024+r32*16; const lds_cptr vp0=shm3+LDS_V+((lane>>4)&1)*32+(lane&3)*8+(4*hi+((lane&15)>>2))*64;
  const int NT=NKEYS/KVBLK;
  DMA_K(0,0);DMA_V(0,0);DMA_K(1,SLOTB);
  bf16x8 qr[4];
  #pragma unroll
  for(int d0=0;d0<4;++d0)qr[d0]=*reinterpret_cast<const bf16x8*>(&Qw[(long)r32*QP+d0*16+hi*8]);
  float mhat=0.f,l_reg=0.f;f32x16 o[2];o[0]=f32x16{};o[1]=f32x16{};f32x16 negm=f32x16{};asm volatile("":"+v"(negm));
    #define CMASK(P0,P1,t) do{}while(0)
  bool resc=false;
  #define START(P0,P1) do{ const float rm=rowmax(P0,P1); resc=false; \
    { const float dl=rm; mhat=fadd_s(mhat,dl); \
      _Pragma("unroll") for(int r=0;r<16;++r){P0[r]=fsub_s(P0[r],dl);P1[r]=fsub_s(P1[r],dl);} \
      _Pragma("unroll") for(int r=0;r<16;++r)negm[r]=-mhat; asm volatile("":"+v"(negm)); } \
    _Pragma("unroll") for(int r=0;r<16;++r)P0[r]=__builtin_amdgcn_exp2f(P0[r]); }while(0)
  #define RESC() do{ if(resc){ asm volatile("s_waitcnt lgkmcnt(0)":::"memory"); \
      _Pragma("unroll") for(int d_=0;d_<2;++d_) _Pragma("unroll") for(int r=0;r<16;++r)o[d_][r]*=wsf[crow(r,hi)]; } }while(0)
  f32x16 pA0,pA1,pB0,pB1;
  int sl_prev=0,sl_cur=0,sl_next=SLOTB;
  #define ROT() do{sl_prev=sl_cur;sl_cur=sl_next;sl_next=(sl_next==(NSLOT-1)*SLOTB)?0:sl_next+SLOTB;}while(0)
  DMA_K(2,2*SLOTB);
  WAIT_BAR(3);
  qkt(pA0,pA1,Kbase,qr,negm,r32,hi);asm volatile("s_nop 15\n\ts_nop 7":"+v"(pA0),"+v"(pA1));CMASK(pA0,pA1,0);
  START(pA0,pA1);
  _Pragma("unroll") for(int r=0;r<16;++r)pA1[r]=__builtin_amdgcn_exp2f(pA1[r]);
  WAIT_BAR(0);
  DMA_K(3,0);DMA_V(1,SLOTB);
  ROT();
  kload8(kf,kp0+sl_cur);
  WAIT_BAR(2);
  s16x4 vlo[8],vhi[8]; u32x4 pw0,pw1,pw2,pw3;
  #define PKW(P,B) cvtpk_s(P[B],P[B+1])
  #define PAF(k) __builtin_bit_cast(bf16x8,pw##k)
  #define VFR(i) (bf16x8){vlo[i][0],vlo[i][1],vlo[i][2],vlo[i][3],vhi[i][0],vhi[i][1],vhi[i][2],vhi[i][3]}
  #define PIN(x) asm volatile("":"+v"(x))
  #define MX3(a,b,c) __builtin_fmaxf(__builtin_fmaxf((a),(b)),(c))
  #define GAPA(MF,A0,A1,A2,A3,W0,W1,PW) do{ MF; sacc+=A0; sacc+=A1; sacc+=A2; sacc+=A3; PIN(sacc); W0; W1; PIN(PW); SBAR(); }while(0)
  #define EX(v) __builtin_amdgcn_exp2f(v)
  #define GAPB(MF,X,B) do{ MF; X[B]=EX(X[B]); X[B+1]=EX(X[B+1]); X[B+2]=EX(X[B+2]); X[B+3]=EX(X[B+3]); PIN(X); SBAR(); }while(0)
  #define VRD(i) do{ vlo[i]=vtr(vp_+(((i)>>2)*4096+((i)&3)*1024)); vhi[i]=vtr(vp_+(((i)>>2)*4096+((i)&3)*1024+512)); }while(0)
  #define KRD(G,j) do{ if(G){ kload2(kf,kp0+sl_next,j); SBAR(); } }while(0)
  #define STEP(C0,C1,P0,P1,t,GK,GV,GL) do{ SBAR(); \
    const lds_cptr vp_=vp0+sl_prev; \
    VRD(0); SBAR(); float sacc=(P0[0]+P0[1]); \
    GAPA(C0=__builtin_amdgcn_mfma_f32_32x32x16_bf16(kf[0],qr[0],negm,0,0,0), P0[2],P0[3],P0[4],P0[5],     pw0[0]=PKW(P0,0), pw0[1]=PKW(P0,2), pw0); \
    VRD(4); SBAR(); GAPA(C1=__builtin_amdgcn_mfma_f32_32x32x16_bf16(kf[1],qr[0],negm,0,0,0), P0[6],P0[7],P0[8],P0[9],     pw0[2]=PKW(P0,4), pw0[3]=PKW(P0,6), pw0); \
    VRD(1); SBAR(); GAPA(C0=__builtin_amdgcn_mfma_f32_32x32x16_bf16(kf[2],qr[1],C0,0,0,0),   P0[10],P0[11],P0[12],P0[13], pw1[0]=PKW(P0,8), pw1[1]=PKW(P0,10), pw1); \
    VRD(5); SBAR(); GAPA(C1=__builtin_amdgcn_mfma_f32_32x32x16_bf16(kf[3],qr[1],C1,0,0,0),   P0[14],P0[15],P1[0],P1[1],   pw1[2]=PKW(P0,12),pw1[3]=PKW(P0,14), pw1); \
    VRD(2); SBAR(); GAPA(C0=__builtin_amdgcn_mfma_f32_32x32x16_bf16(kf[4],qr[2],C0,0,0,0),   P1[2],P1[3],P1[4],P1[5],     pw2[0]=PKW(P1,0), pw2[1]=PKW(P1,2), pw2); \
    VRD(6); SBAR(); GAPA(C1=__builtin_amdgcn_mfma_f32_32x32x16_bf16(kf[5],qr[2],C1,0,0,0),   P1[6],P1[7],P1[8],P1[9],     pw2[2]=PKW(P1,4), pw2[3]=PKW(P1,6), pw2); \
    VRD(3); SBAR(); GAPA(C0=__builtin_amdgcn_mfma_f32_32x32x16_bf16(kf[6],qr[3],C0,0,0,0),   P1[10],P1[11],P1[12],P1[13], pw3[0]=PKW(P1,8), pw3[1]=PKW(P1,10), pw3); \
    VRD(7); SBAR(); GAPA(C1=__builtin_amdgcn_mfma_f32_32x32x16_bf16(kf[7],qr[3],C1,0,0,0),   P1[14],P1[15],0.f,0.f,       pw3[2]=PKW(P1,12),pw3[3]=PKW(P1,14), pw3); \
    l_reg+=sacc; \
    if(GK){DMA_K((t)+3,sl_cur);} if(GV){DMA_V((t)+1,sl_next);} \
    CMASK(C0,C1,t); \
    { float a=MX3(C0[0],C0[1],C1[0]),b=MX3(C0[2],C0[3],C1[1]); a=MX3(a,C1[2],C1[3]); \
      _Pragma("unroll") for(int r=4;r<16;r+=4){a=MX3(a,C0[r],C0[r+1]);b=MX3(b,C0[r+2],C0[r+3]);a=MX3(a,C1[r],C1[r+1]);b=MX3(b,C1[r+2],C1[r+3]);} \
      float rm=__builtin_fmaxf(a,b); { auto rr=__builtin_amdgcn_permlane32_swap(__float_as_uint(rm),__float_as_uint(rm),false,false); rm=__builtin_fmaxf(__uint_as_float(rr[0]),__uint_as_float(rr[1])); } \
      resc=false; \
      if(__builtin_expect(__any(rm>(float)THRL),0)){ const float dl=__builtin_fmaxf(rm,0.f); mhat+=dl; \
        _Pragma("unroll") for(int r=0;r<16;++r){C0[r]-=dl;C1[r]-=dl;} \
        _Pragma("unroll") for(int r=0;r<16;++r)negm[r]=-mhat; asm volatile("":"+v"(negm)); \
        const float f=__builtin_amdgcn_exp2f(-dl); l_reg*=f; if(hi==0)wsf[r32]=f; resc=true; } } \
    SBAR(); \
    GAPB(o[0]=__builtin_amdgcn_mfma_f32_32x32x16_bf16(PAF(0),VFR(0),o[0],0,0,0), C0,0); \
    GAPB(o[1]=__builtin_amdgcn_mfma_f32_32x32x16_bf16(PAF(0),VFR(4),o[1],0,0,0), C0,4); \
    KRD(GL,0); GAPB(o[0]=__builtin_amdgcn_mfma_f32_32x32x16_bf16(PAF(1),VFR(1),o[0],0,0,0), C0,8); \
    KRD(GL,1); GAPB(o[1]=__builtin_amdgcn_mfma_f32_32x32x16_bf16(PAF(1),VFR(5),o[1],0,0,0), C0,12); \
    KRD(GL,2); GAPB(o[0]=__builtin_amdgcn_mfma_f32_32x32x16_bf16(PAF(2),VFR(2),o[0],0,0,0), C1,0); \
    KRD(GL,3); GAPB(o[1]=__builtin_amdgcn_mfma_f32_32x32x16_bf16(PAF(2),VFR(6),o[1],0,0,0), C1,4); \
    GAPB(o[0]=__builtin_amdgcn_mfma_f32_32x32x16_bf16(PAF(3),VFR(3),o[0],0,0,0), C1,8); \
    GAPB(o[1]=__builtin_amdgcn_mfma_f32_32x32x16_bf16(PAF(3),VFR(7),o[1],0,0,0), C1,12); \
    }while(0)
  int t=1;
  #undef CMASK
  #define CMASK(P0,P1,t) do{}while(0)
  for(;t+5<NT;t+=2){
    STEP(pB0,pB1,pA0,pA1,t,true,true,true);     WAIT_BAR(2); RESC(); ROT();
    STEP(pA0,pA1,pB0,pB1,t+1,true,true,true);   WAIT_BAR(2); RESC(); ROT();
  }
  #undef CMASK
  #define CMASK(P0,P1,t) do{}while(0)
  #define ENDW(tt) do{ if((tt)+3<NT){WAIT_BAR(2);} else if((tt)+2<NT){WAIT_BAR(1);} else {WAIT_BAR(0);} }while(0)
  for(;t+1<NT;t+=2){
    STEP(pB0,pB1,pA0,pA1,t,(t+3<NT),(t+1<NT),(t+1<NT));       ENDW(t);   RESC(); ROT();
    STEP(pA0,pA1,pB0,pB1,t+1,(t+4<NT),(t+2<NT),(t+2<NT));     ENDW(t+1); RESC(); ROT();
  }
  STEP(pB0,pB1,pA0,pA1,NT-1,false,false,false); RESC();
  { float sacc=pB0[0]+pB0[1]; _Pragma("unroll") for(int r=2;r<16;++r)sacc+=pB0[r]; _Pragma("unroll") for(int r=0;r<16;++r)sacc+=pB1[r]; l_reg+=sacc;
    pw0=(u32x4){PKW(pB0,0),PKW(pB0,2),PKW(pB0,4),PKW(pB0,6)};pw1=(u32x4){PKW(pB0,8),PKW(pB0,10),PKW(pB0,12),PKW(pB0,14)};pw2=(u32x4){PKW(pB1,0),PKW(pB1,2),PKW(pB1,4),PKW(pB1,6)};pw3=(u32x4){PKW(pB1,8),PKW(pB1,10),PKW(pB1,12),PKW(pB1,14)};
    SBAR(); pv(o,vb0+sl_cur,PAF(0),PAF(1),PAF(2),PAF(3)); }
  #undef PKW
  #undef PAF
  #undef VFR
  #undef PIN
  #undef MX3
  #undef GAPA
  #undef GAPB
  #undef EX
  #undef VRD
  #undef KRD
  #undef STEP
  #undef ENDW
  {auto rr=__builtin_amdgcn_permlane32_swap(__float_as_uint(l_reg),__float_as_uint(l_reg),false,false);l_reg=__uint_as_float(rr[0])+__uint_as_float(rr[1]);}
  if(hi==0)wsf[32+r32]=l_reg;asm volatile("s_waitcnt lgkmcnt(0)":::"memory");
  float rli[16];
  #pragma unroll
  for(int r=0;r<16;++r)rli[r]=__builtin_amdgcn_rcpf(wsf[32+crow(r,hi)]);
  bf16*Ow=O+(long)(q0+wid*QBLK)*OP+hq*D;
  { bf16*stg=(bf16*)(shm+LDS_OST)+wid*2048;
    #pragma unroll
    for(int r=0;r<16;++r){const int orow=crow(r,hi);
      #pragma unroll
      for(int d0=0;d0<2;++d0)stg[orow*64+d0*32+r32]=__float2bfloat16(o[d0][r]*rli[r]);}
    asm volatile("s_waitcnt lgkmcnt(0)":::"memory");
    #pragma unroll
    for(int i=0;i<4;++i){const int row=i*8+(lane>>3),ch=lane&7; const u32x4 v=*(const u32x4*)(stg+row*64+ch*8); ATTN_STORE16(Ow+(long)row*OP+ch*8,v);} }
  asm volatile("s_waitcnt lgkmcnt(0)\n\ts_barrier":::"memory");
  #undef DMA_K
  #undef DMA_V
  #undef CMASK
  #undef START
  #undef RESC
  #undef ROT
}
constexpr int ATTN_LDS_BYTES=LDS_BYTES;
struct AttnTensors { const bf16* Q; const bf16* K; const bf16* V; bf16* O; };
struct AttnUnit { int hq; int kvh; int qb; };
struct GqaOrder {
  int vcu;
  __device__ __forceinline__ explicit GqaOrder(int grid,int block):vcu((block%8)*(grid/8)+block/8){}
  __device__ __forceinline__ bool next(int i,AttnUnit&u)const{ if(i>=3)return false; const int x=vcu>>5; u.kvh=x>>1; u.hq=u.kvh*3+i; u.qb=(x&1)*32+(vcu&31); return true; }
};
template<class Sched,int THRL=8> __device__ __forceinline__ void attn_phase(char*lds,const AttnTensors&T,const Sched&S){
  AttnUnit u;
  for(int i=0;S.next(i,u);++i){ attn_unit<THRL>(u.hq,u.kvh,u.qb,T.Q,T.K,T.V,T.O,lds); }
}
#undef SBAR
#undef WAIT_BAR
}


constexpr int NWAVES = 8;
#ifndef MK_N_LAUNCHES
#define MK_N_LAUNCHES 1
#endif
constexpr int NPH = 18;

constexpr int SEQ = 16384, DMODEL = 1024, CTXL = 256, MROWS = SEQ + CTXL;
constexpr int NQKVF = 1536, KCOL = 768, VCOL = 1024, FCOL = 1280;
constexpr int DFF = 2816, DEXP = 3584, NEXP = 8;
constexpr int MOE_TILES_MAX = 136;
constexpr float NEPS = 1e-6f;

constexpr size_t MiB = 1u << 20;
constexpr size_t WS_CTL = 0, CTL_ZERO_BYTES = 1 * MiB;
constexpr size_t WS_SMALL = 1 * MiB;
constexpr size_t SM_MOD0 = 0, SM_MOD1 = 32768, SM_CMOD = 65536, SM_BLKCNT = 81920, SM_TILEE = 98304, SM_TOKE = 131072, SM_TOKW = 262144, SM_TOKR = 393216, SM_TOKP = 524288;
constexpr size_t WS_WEGU = 2 * MiB, WS_WEDN = 58 * MiB, WS_WIN0 = 86 * MiB, WS_WOUT0 = 89 * MiB, WS_WGU0 = 91 * MiB, WS_WDN0 = 102 * MiB, WS_WIN1 = 108 * MiB, WS_WOUT1 = 114 * MiB;
constexpr size_t WS_H = 116 * MiB, WS_QKVF = 149 * MiB, WS_PB = 198 * MiB, WS_QB = 206 * MiB, WS_MIX = 214 * MiB, WS_Y = 246 * MiB;
constexpr size_t WS_ACT0 = 149 * MiB, WS_BCU = 149 * MiB, WS_VB = 278 * MiB;
constexpr size_t WS_H2 = 310 * MiB, WS_HPERM = 326 * MiB, WS_YP = 360 * MiB, WS_ACT1 = 149 * MiB, WS_END = 428 * MiB;
static_assert(WS_WEGU + (size_t)NEXP * DMODEL * 2 * DEXP <= WS_WEDN && WS_WEDN + (size_t)NEXP * DMODEL * DEXP <= WS_WIN0 && WS_WOUT1 + 2 * MiB <= WS_H, "weights");
static_assert(WS_H + (size_t)MROWS * DMODEL * 2 <= WS_QKVF && WS_QKVF + (size_t)MROWS * NQKVF * 2 <= WS_PB && WS_MIX + (size_t)SEQ * DMODEL * 2 <= WS_Y, "layer-0 mixer map");
static_assert(WS_ACT0 + (size_t)SEQ * DFF * 2 <= WS_Y && WS_BCU + (size_t)SEQ * 3 * DMODEL * 2 <= WS_Y && WS_Y + (size_t)SEQ * DMODEL * 2 <= WS_VB && WS_VB + (size_t)SEQ * DMODEL * 2 <= WS_H2, "ffn / conv map");
static_assert(WS_H2 + (size_t)SEQ * DMODEL <= WS_HPERM && WS_HPERM + (size_t)MOE_TILES_MAX * 256 * DMODEL <= WS_YP && WS_YP + (size_t)MOE_TILES_MAX * 256 * DMODEL * 2 <= WS_END && WS_ACT1 + (size_t)MOE_TILES_MAX * 256 * DEXP <= WS_H2, "moe map");
constexpr float WSCALE_GU = 64.f, WSCALE_DN = 128.f;
constexpr int CW_BAR = 4096;

constexpr int RING_OFF = 0, RING_BYTES = 131072;
constexpr int LDSCTL_OFF = RING_BYTES;
constexpr int LDS_BYTES = 147456;

#define GAS __attribute__((address_space(1)))
#define LAS __attribute__((address_space(3)))
typedef unsigned short bf16;
typedef unsigned v4u __attribute__((ext_vector_type(4)));
typedef unsigned v2u __attribute__((ext_vector_type(2)));
typedef float f32x4 __attribute__((ext_vector_type(4)));
typedef short bf16x8 __attribute__((ext_vector_type(8)));
typedef GAS unsigned gu32;
__device__ __forceinline__ unsigned f2bf(float f) { unsigned u = __builtin_bit_cast(unsigned, f); return (u + 0x7fffu + ((u >> 16) & 1u)) >> 16; }
__device__ __forceinline__ unsigned pk2(float lo, float hi) { return f2bf(lo) | (f2bf(hi) << 16); }
__device__ __forceinline__ float bflo(unsigned w) { return __builtin_bit_cast(float, w << 16); }
__device__ __forceinline__ float bfhi(unsigned w) { return __builtin_bit_cast(float, w & 0xffff0000u); }
__device__ __forceinline__ float fast_exp(float x) { return __builtin_amdgcn_exp2f(x * 1.4426950408889634f); }
__device__ __forceinline__ float silu_f(float x) { return x * __builtin_amdgcn_rcpf(1.0f + fast_exp(-x)); }
__device__ __forceinline__ float wave_sum(float v) {
#pragma unroll
    for (int o = 1; o < 64; o <<= 1) v += __shfl_xor(v, o);
    return v;
}
__device__ __forceinline__ float sum4(f32x4 v) { return (v.x + v.y) + (v.z + v.w); }
__device__ __forceinline__ f32x4 ld_bf4(const bf16* p) { const v2u w = *(const v2u*)p; return (f32x4){bflo(w.x), bfhi(w.x), bflo(w.y), bfhi(w.y)}; }
__device__ __forceinline__ void st_bf4(bf16* p, f32x4 v) { v2u w; w.x = pk2(v.x, v.y); w.y = pk2(v.z, v.w); *(v2u*)p = w; }

#define XB_TMO      128
#define XB_XCNT(j)  (256  + 64 * (j))
#define XB_XSUB(j)  (1280 + 64 * (j))
#define XB_XGEN(j)  (2304 + 64 * (j))
#define XB_TOP      3328
#define XB_TOPGEN   3392
#define XCD_BAR_WORDS 3456
#define XB_SPIN_CAP (1u << 18)

__device__ __forceinline__ unsigned xb_ld(unsigned* p)              { return __hip_atomic_load(p, __ATOMIC_RELAXED, __HIP_MEMORY_SCOPE_AGENT); }
__device__ __forceinline__ unsigned xb_add(unsigned* p, unsigned v) { return __hip_atomic_fetch_add(p, v, __ATOMIC_RELAXED, __HIP_MEMORY_SCOPE_AGENT); }
__device__ __forceinline__ unsigned xb_xcc_id() { return (unsigned)__builtin_amdgcn_s_getreg((3 << 11) | 20) & 0xFu; }
#define XB_SPIN(cond, bar) do { unsigned _sp = 0; while (cond) { __builtin_amdgcn_s_sleep(1); \
    if ((++_sp & 255u) == 0u) { if (xb_ld(&(bar)[XB_TMO])) break; if (_sp > XB_SPIN_CAP) { atomicAdd(&(bar)[XB_TMO], 1u); break; } } } } while (0)

struct XcdBarrier {
    unsigned* bar; unsigned x;
    volatile LAS unsigned* st;
};

__device__ __forceinline__ XcdBarrier xcd_barrier_post(unsigned* bar, volatile LAS unsigned* st) {
    XcdBarrier b; b.bar = bar; b.x = xb_xcc_id(); b.st = st;
    if (threadIdx.x == 0) (void)xb_add(&bar[XB_XCNT(b.x)], 1u);
    return b;
}
__device__ __forceinline__ void xcd_barrier_complete(unsigned* bar, unsigned x, unsigned& nloc, unsigned& nx) {
    const unsigned G = gridDim.x * gridDim.y * gridDim.z;
    unsigned sum, cnt, mine, sp = 0u;
    for (;;) {
        sum = 0u; cnt = 0u; mine = 0u;
#pragma unroll
        for (unsigned j = 0; j < 16; ++j) { const unsigned c = xb_ld(&bar[XB_XCNT(j)]); sum += c; cnt += (c > 0u) ? 1u : 0u; mine = (j == x) ? c : mine; }
        if (sum == G) break;
        __builtin_amdgcn_s_sleep(1);
        if ((++sp & 255u) == 0u) { if (xb_ld(&bar[XB_TMO])) break; if (sp > XB_SPIN_CAP) { atomicAdd(&bar[XB_TMO], 1u); break; } }
    }
    nloc = mine > 0u ? mine : 1u; nx = cnt > 0u ? cnt : 1u;
}

__device__ __forceinline__ void xcd_barrier(const XcdBarrier& b) {
    asm volatile("s_waitcnt vmcnt(0)" ::: "memory");
    __syncthreads();
    if (threadIdx.x == 0) {
        unsigned* bar = b.bar;
        __builtin_amdgcn_s_waitcnt(0);
        unsigned nloc = b.st[0], nx = b.st[1];
        if (nloc == 0u) { xcd_barrier_complete(bar, b.x, nloc, nx); b.st[0] = nloc; b.st[1] = nx; }
        const unsigned old = xb_add(&bar[XB_XSUB(b.x)], 1u);
        const unsigned gen = old / nloc;
        if (old + 1u == (gen + 1u) * nloc) {
            __builtin_amdgcn_fence(__ATOMIC_RELEASE, "agent");
            asm volatile("s_waitcnt vmcnt(0)" ::: "memory");
            const unsigned og = xb_add(&bar[XB_TOP], 1u);
            const unsigned tg = og / nx;
            if (og + 1u == (tg + 1u) * nx) xb_add(&bar[XB_TOPGEN], 1u);
            else XB_SPIN(xb_ld(&bar[XB_TOPGEN]) == tg, bar);
            __builtin_amdgcn_fence(__ATOMIC_ACQUIRE, "agent");
            xb_add(&bar[XB_XGEN(b.x)], 1u);
            asm volatile("s_waitcnt vmcnt(0)" ::: "memory");
        } else {
            XB_SPIN(xb_ld(&bar[XB_XGEN(b.x)]) == gen, bar);
            __builtin_amdgcn_fence(__ATOMIC_ACQUIRE, "agent");
            asm volatile("s_waitcnt vmcnt(0)" ::: "memory");
        }
    }
    __syncthreads();
}


struct Ctx {
    LAS unsigned char* lds;
    int tid, lane, wave, vcu, G, blk;
    const float* in[21]; float* out; unsigned char* ws;
};
#define WSP(T, off) ((T*)(C.ws + (off)))
#define SMP(T, off) ((T*)(C.ws + WS_SMALL + (off)))

__device__ __forceinline__ void p0_transpose_item(const float* W, int K, int N, bf16* WT, int inter, int up, LAS float* scr, int item, int lane) {
    const int nblk = N / 32, kb = item / nblk, nb = item % nblk, k0 = 64 * kb, n0 = 32 * nb;
    const int drow0 = inter ? ((n0 >> 7) * 256 + (n0 & 127) + (up ? 128 : 0)) : n0;
#pragma unroll 8
    for (int i = 0; i < 32; ++i) { const int kk = 2 * i + (lane >> 5); scr[kk * 33 + (lane & 31)] = W[(size_t)(k0 + kk) * N + n0 + (lane & 31)]; }
    asm volatile("s_waitcnt lgkmcnt(0)" ::: "memory");
    const int c = lane & 7;
#pragma unroll
    for (int j = 0; j < 4; ++j) { const int n = (lane >> 3) + 8 * j; const LAS float* s = scr + (8 * c) * 33 + n;
        v4u o; o.x = pk2(s[0 * 33], s[1 * 33]); o.y = pk2(s[2 * 33], s[3 * 33]); o.z = pk2(s[4 * 33], s[5 * 33]); o.w = pk2(s[6 * 33], s[7 * 33]);
        *(v4u*)(WT + (size_t)(drow0 + n) * K + k0 + 8 * c) = o; }
    asm volatile("s_waitcnt lgkmcnt(0)" ::: "memory");
}
__device__ __forceinline__ float clamp448f(float x) { return __builtin_fminf(__builtin_fmaxf(x, -448.f), 448.f); }
__device__ __forceinline__ unsigned pk4_fp8(float a, float b, float c, float d) { int w = 0; w = __builtin_amdgcn_cvt_pk_fp8_f32(a, b, w, false); w = __builtin_amdgcn_cvt_pk_fp8_f32(c, d, w, true); return (unsigned)w; }
__device__ __forceinline__ void p0_transpose_item_f8(const float* W, int K, int N, unsigned char* WT, int inter, int up, float scale, LAS float* scr, int item, int lane) {
    const int nblk = N / 32, kb = item / nblk, nb = item % nblk, k0 = 64 * kb, n0 = 32 * nb;
    const int drow0 = inter ? ((n0 >> 7) * 256 + (n0 & 127) + (up ? 128 : 0)) : n0;
#pragma unroll 8
    for (int i = 0; i < 32; ++i) { const int kk = 2 * i + (lane >> 5); scr[kk * 33 + (lane & 31)] = W[(size_t)(k0 + kk) * N + n0 + (lane & 31)] * scale; }
    asm volatile("s_waitcnt lgkmcnt(0)" ::: "memory");
    const int n = lane >> 1, hf = lane & 1; const LAS float* s = scr + (32 * hf) * 33 + n;
    v4u o0, o1;
    o0.x = pk4_fp8(s[0 * 33], s[1 * 33], s[2 * 33], s[3 * 33]);     o0.y = pk4_fp8(s[4 * 33], s[5 * 33], s[6 * 33], s[7 * 33]);
    o0.z = pk4_fp8(s[8 * 33], s[9 * 33], s[10 * 33], s[11 * 33]);   o0.w = pk4_fp8(s[12 * 33], s[13 * 33], s[14 * 33], s[15 * 33]);
    o1.x = pk4_fp8(s[16 * 33], s[17 * 33], s[18 * 33], s[19 * 33]); o1.y = pk4_fp8(s[20 * 33], s[21 * 33], s[22 * 33], s[23 * 33]);
    o1.z = pk4_fp8(s[24 * 33], s[25 * 33], s[26 * 33], s[27 * 33]); o1.w = pk4_fp8(s[28 * 33], s[29 * 33], s[30 * 33], s[31 * 33]);
    unsigned char* dst = WT + (size_t)(drow0 + n) * K + k0 + 32 * hf;
    *(v4u*)dst = o0; *(v4u*)(dst + 16) = o1;
    asm volatile("s_waitcnt lgkmcnt(0)" ::: "memory");
}
__device__ __forceinline__ void p0_adaln_item(const Ctx& C, int it) {
    const int layer = it / 96, n0 = (it % 96) * 64;
    const float* W = C.in[4] + (size_t)layer * DMODEL * 6144;
    const float* cvec = C.in[1]; const float* cctx = C.in[3];
    const int cq = C.tid & 15, kp = C.tid >> 4;
    f32x4 a = {0.f, 0.f, 0.f, 0.f}, ac = {0.f, 0.f, 0.f, 0.f};
#pragma unroll 4
    for (int i = 0; i < 32; ++i) { const int k = kp * 32 + i; const float s = silu_f(cvec[k]), sc = silu_f(cctx[k]);
        const f32x4 w = *(const f32x4*)(W + (size_t)k * 6144 + n0 + 4 * cq); a += s * w; ac += sc * w; }
    LAS float* scr = (LAS float*)C.lds;
    *(LAS f32x4*)(scr + kp * 64 + 4 * cq) = a; *(LAS f32x4*)(scr + 2048 + kp * 64 + 4 * cq) = ac;
    __syncthreads();
    if (C.tid < 128) { const int which = C.tid >> 6, col = C.tid & 63; float s = 0.f;
        for (int q = 0; q < 32; ++q) s += scr[which * 2048 + q * 64 + col];
        const int n = n0 + col; const float b = C.in[5][layer * 6144 + n];
        if (which == 0) SMP(float, layer ? SM_MOD1 : SM_MOD0)[n] = s + b;
        else if (layer == 0 && n < 2048) SMP(float, SM_CMOD)[n] = s + b; }
    __syncthreads();
}
__device__ __forceinline__ void p0_prologue(const Ctx& C) {
    for (int it = C.blk; it < 192; it += C.G) p0_adaln_item(C, it);
    LAS float* scr = (LAS float*)(C.lds + C.wave * 16384);
    const int gw = C.vcu * NWAVES + C.wave, NGW = C.G * NWAVES;
    constexpr int I_IN0 = 16 * 48, I_OUT = 16 * 32, I_G0 = 16 * 88, I_D0 = 44 * 32, I_IN1 = 16 * 96, I_EG = 16 * 112, I_ED = 56 * 32;
    constexpr int NITEMS = I_IN0 + I_OUT + 2 * I_G0 + I_D0 + I_IN1 + I_OUT + 8 * (2 * I_EG + I_ED);
    for (int it = gw; it < NITEMS; it += NGW) {
        int r = it;
        if (r < I_IN0) { p0_transpose_item(C.in[7], 1024, 1536, WSP(bf16, WS_WIN0), 0, 0, scr, r, C.lane); continue; } r -= I_IN0;
        if (r < I_OUT) { p0_transpose_item(C.in[10], 1024, 1024, WSP(bf16, WS_WOUT0), 0, 0, scr, r, C.lane); continue; } r -= I_OUT;
        if (r < I_G0) { p0_transpose_item(C.in[11], 1024, DFF, WSP(bf16, WS_WGU0), 1, 0, scr, r, C.lane); continue; } r -= I_G0;
        if (r < I_G0) { p0_transpose_item(C.in[12], 1024, DFF, WSP(bf16, WS_WGU0), 1, 1, scr, r, C.lane); continue; } r -= I_G0;
        if (r < I_D0) { p0_transpose_item(C.in[13], DFF, 1024, WSP(bf16, WS_WDN0), 0, 0, scr, r, C.lane); continue; } r -= I_D0;
        if (r < I_IN1) { p0_transpose_item(C.in[14], 1024, 3072, WSP(bf16, WS_WIN1), 0, 0, scr, r, C.lane); continue; } r -= I_IN1;
        if (r < I_OUT) { p0_transpose_item(C.in[16], 1024, 1024, WSP(bf16, WS_WOUT1), 0, 0, scr, r, C.lane); continue; } r -= I_OUT;
        const int per_e = 2 * I_EG + I_ED, e = r / per_e; r -= e * per_e;
        if (r < I_EG) { p0_transpose_item_f8(C.in[18] + (size_t)e * 1024 * DEXP, 1024, DEXP, WSP(unsigned char, WS_WEGU) + (size_t)e * 2 * DEXP * 1024, 1, 0, WSCALE_GU, scr, r, C.lane); continue; } r -= I_EG;
        if (r < I_EG) { p0_transpose_item_f8(C.in[19] + (size_t)e * 1024 * DEXP, 1024, DEXP, WSP(unsigned char, WS_WEGU) + (size_t)e * 2 * DEXP * 1024, 1, 1, WSCALE_GU, scr, r, C.lane); continue; } r -= I_EG;
        p0_transpose_item_f8(C.in[20] + (size_t)e * DEXP * 1024, DEXP, 1024, WSP(unsigned char, WS_WEDN) + (size_t)e * 1024 * DEXP, 0, 0, WSCALE_DN, scr, r, C.lane);
    }
}

__device__ __forceinline__ void p1_modulate(const Ctx& C) {
    LAS float* V = (LAS float*)C.lds;
    const float* g = C.in[6]; const float* mod = SMP(float, SM_MOD0); const float* cmod = SMP(float, SM_CMOD);
    for (int c = C.tid; c < 1024; c += 512) { V[c] = g[c] * (1.f + mod[1024 + c]); V[1024 + c] = mod[c]; V[2048 + c] = g[c] * (1.f + cmod[1024 + c]); V[3072 + c] = cmod[c]; }
    __syncthreads();
    const int gw = C.vcu * NWAVES + C.wave, NGW = C.G * NWAVES; bf16* H = WSP(bf16, WS_H);
    for (int m = gw; m < MROWS; m += NGW) {
        const float* src = (m < SEQ) ? C.in[0] + (size_t)m * 1024 : C.in[2] + (size_t)(m - SEQ) * 1024;
        const LAS float* VA = V + ((m < SEQ) ? 0 : 2048); const LAS float* VB = VA + 1024;
        f32x4 v[4]; float ss = 0.f;
#pragma unroll
        for (int j = 0; j < 4; ++j) { v[j] = *(const f32x4*)(src + 4 * C.lane + 256 * j); ss += sum4(v[j] * v[j]); }
        const float r = __builtin_amdgcn_rsqf(wave_sum(ss) * (1.f / 1024.f) + NEPS);
#pragma unroll
        for (int j = 0; j < 4; ++j) { const int c = 4 * C.lane + 256 * j; const f32x4 a = *(const LAS f32x4*)(VA + c), b = *(const LAS f32x4*)(VB + c);
            st_bf4(H + (size_t)m * 1024 + c, v[j] * r * a + b); }
    }
    __syncthreads();
}
template <int MODE>
__device__ __forceinline__ void post_rows(const Ctx& C, const float* gt, const float* gpost, const float* gpre, const float* sc, const float* sh,
                                          const float* xsrc, const bf16* ysrc, float* xdst, bf16* hdst) {
    LAS float* V = (LAS float*)C.lds;
    LAS float* RT = V + 3072;
    LAS int* SEL = (LAS int*)(V + 3072 + 8192);
    LAS int* RNK = SEL + 128;
    for (int c = C.tid; c < 1024; c += 512) { V[c] = gt[c] * gpost[c];
        if (MODE != 3) { V[1024 + c] = gpre[c] * (1.f + sc[c]); V[2048 + c] = sh[c]; } }
    if (MODE == 2) { const float* R = C.in[17]; for (int i = C.tid; i < 8192; i += 512) { const int c = i >> 3, e = i & 7; RT[e * 1024 + c] = R[i]; } }
    __syncthreads();
    const int rows_per_blk = SEQ / C.G, rows_per_wave = rows_per_blk / NWAVES;
    for (int i = 0; i < rows_per_wave; ++i) {
        const int rl = C.wave * rows_per_wave + i, m = C.blk * rows_per_blk + rl;
        f32x4 xv[4], yv[4]; float ss = 0.f;
        if (MODE == 3) {
            const int* tp = SMP(int, SM_TOKP) + 2 * m; const float* tw = SMP(float, SM_TOKW) + 2 * m;
            const int p0 = tp[0], p1 = tp[1]; const float w0 = tw[0], w1 = tw[1];
            const bf16* y0 = WSP(bf16, WS_YP) + (size_t)p0 * 1024; const bf16* y1 = WSP(bf16, WS_YP) + (size_t)p1 * 1024;
#pragma unroll
            for (int j = 0; j < 4; ++j) { const int c = 4 * C.lane + 256 * j; yv[j] = w0 * ld_bf4(y0 + c) + w1 * ld_bf4(y1 + c); }
        } else {
#pragma unroll
            for (int j = 0; j < 4; ++j) yv[j] = ld_bf4(ysrc + (size_t)m * 1024 + 4 * C.lane + 256 * j);
        }
#pragma unroll
        for (int j = 0; j < 4; ++j) { xv[j] = *(const f32x4*)(xsrc + (size_t)m * 1024 + 4 * C.lane + 256 * j); ss += sum4(yv[j] * yv[j]); }
        const float ry = __builtin_amdgcn_rsqf(wave_sum(ss) * (1.f / 1024.f) + NEPS);
        float s1 = 0.f;
#pragma unroll
        for (int j = 0; j < 4; ++j) { const int c = 4 * C.lane + 256 * j; xv[j] += *(const LAS f32x4*)(V + c) * (yv[j] * ry); s1 += sum4(xv[j] * xv[j]);
            *(f32x4*)(xdst + (size_t)m * 1024 + c) = xv[j]; }
        if (MODE == 3) continue;
        const float r1 = __builtin_amdgcn_rsqf(wave_sum(s1) * (1.f / 1024.f) + NEPS);
        f32x4 la = {0.f, 0.f, 0.f, 0.f}, lb = {0.f, 0.f, 0.f, 0.f};
#pragma unroll
        for (int j = 0; j < 4; ++j) { const int c = 4 * C.lane + 256 * j;
            const f32x4 h = xv[j] * r1 * *(const LAS f32x4*)(V + 1024 + c) + *(const LAS f32x4*)(V + 2048 + c);
            if (MODE == 2) *(unsigned*)((unsigned char*)hdst + (size_t)m * 1024 + c) = pk4_fp8(clamp448f(h.x), clamp448f(h.y), clamp448f(h.z), clamp448f(h.w));
            else st_bf4(hdst + (size_t)m * 1024 + c, h);
            if (MODE == 2) {
#pragma unroll
                for (int e = 0; e < 4; ++e) { la[e] += sum4(h * *(const LAS f32x4*)(RT + e * 1024 + c)); lb[e] += sum4(h * *(const LAS f32x4*)(RT + (4 + e) * 1024 + c)); }
            }
        }
        if (MODE == 2) {
#pragma unroll
            for (int e = 0; e < 4; ++e) { la[e] = wave_sum(la[e]); lb[e] = wave_sum(lb[e]); }
            int e0 = 0; float l0 = la[0];
#pragma unroll
            for (int e = 1; e < 8; ++e) { const float le = e < 4 ? la[e & 3] : lb[e & 3]; if (le > l0) { l0 = le; e0 = e; } }
            int e1 = -1; float l1 = -INFINITY;
#pragma unroll
            for (int e = 0; e < 8; ++e) { const float le = e < 4 ? la[e & 3] : lb[e & 3]; if (e != e0 && le > l1) { l1 = le; e1 = e; } }
            const float w0 = __builtin_amdgcn_rcpf(1.f + fast_exp(l1 - l0)), w1 = 1.f - w0;
            if (C.lane == 0) { int* te = SMP(int, SM_TOKE) + 2 * m; te[0] = e0; te[1] = e1; float* tw = SMP(float, SM_TOKW) + 2 * m; tw[0] = w0; tw[1] = w1;
                SEL[2 * rl] = e0; SEL[2 * rl + 1] = e1; }
        }
    }
    if (MODE == 2) {
        __syncthreads();
        if (C.tid < 8) { int cnt = 0; for (int q = 0; q < 2 * rows_per_blk; ++q) if (SEL[q] == C.tid) { RNK[q] = cnt; ++cnt; }
            SMP(int, SM_BLKCNT)[C.blk * 8 + C.tid] = cnt; }
        __syncthreads();
        if (C.tid < 2 * rows_per_blk) SMP(int, SM_TOKR)[C.blk * 2 * rows_per_blk + C.tid] = RNK[C.tid];
    }
    __syncthreads();
}

__device__ __forceinline__ void p3_qknorm_rope(const Ctx& C) {
    const int gw = C.vcu * NWAVES + C.wave, NGW = C.G * NWAVES; bf16* QK = WSP(bf16, WS_QKVF);
    const int hd = C.lane >> 2, sub = C.lane & 3; const bool isq = hd < 12;
    const float* gain = isq ? C.in[8] : C.in[9];
    f32x4 g0 = *(const f32x4*)(gain + 4 * sub), g1 = *(const f32x4*)(gain + 16 + 4 * sub), g2 = *(const f32x4*)(gain + 32 + 4 * sub), g3 = *(const f32x4*)(gain + 48 + 4 * sub);
    f32x4 invf;
#pragma unroll
    for (int e = 0; e < 4; ++e) invf[e] = __builtin_amdgcn_exp2f(-(float)(4 * sub + e) * (13.287712379549449f / 16.f));
    const float qs = isq ? (0.125f * 1.4426950408889634f) : 1.f;
    for (int m = gw; m < MROWS; m += NGW) {
        if (m >= SEQ && isq) continue;
        bf16* p = QK + (size_t)m * NQKVF + hd * 64 + 4 * sub;
        f32x4 a0 = ld_bf4(p), a1 = ld_bf4(p + 16), b0 = ld_bf4(p + 32), b1 = ld_bf4(p + 48);
        float ss = sum4(a0 * a0) + sum4(a1 * a1) + sum4(b0 * b0) + sum4(b1 * b1);
        ss += __shfl_xor(ss, 1); ss += __shfl_xor(ss, 2);
        const float r = __builtin_amdgcn_rsqf(ss * (1.f / 64.f) + NEPS) * qs;
        a0 = a0 * r * g0; a1 = a1 * r * g1; b0 = b0 * r * g2; b1 = b1 * r * g3;
        if (m < SEQ) {
            const float rp = (float)(m >> 6), cp = (float)(m & 63);
            f32x4 o0, o1, o2, o3;
#pragma unroll
            for (int e = 0; e < 4; ++e) {
                const float ar = (rp * invf[e]) * 0.15915494309189535f, ac = (cp * invf[e]) * 0.15915494309189535f;
                const float cr = __builtin_amdgcn_cosf(ar), sr = __builtin_amdgcn_sinf(ar), cc = __builtin_amdgcn_cosf(ac), sc = __builtin_amdgcn_sinf(ac);
                o0[e] = a0[e] * cr - a1[e] * sr; o1[e] = a0[e] * sr + a1[e] * cr; o2[e] = b0[e] * cc - b1[e] * sc; o3[e] = b0[e] * sc + b1[e] * cc; }
            a0 = o0; a1 = o1; b0 = o2; b1 = o3;
        }
        st_bf4(p, a0); st_bf4(p + 16, a1); st_bf4(p + 32, b0); st_bf4(p + 48, b1);
    }
}

__device__ __forceinline__ void dft128_frags(int wave, int fr, int kg, bf16x8 (&dc)[4], bf16x8 (&ds)[4]) {
#pragma unroll
    for (int ks = 0; ks < 4; ++ks)
#pragma unroll
        for (int i = 0; i < 8; ++i) { const int k = 16 * wave + fr, t = 32 * ks + 8 * kg + i; const float f = (float)((k * t) & 127) * (1.f / 128.f);
            dc[ks][i] = (short)f2bf(__builtin_amdgcn_cosf(f)); ds[ks][i] = (short)f2bf(__builtin_amdgcn_sinf(f)); }
}
__device__ __forceinline__ bf16x8 neg8(bf16x8 v) { v4u u = __builtin_bit_cast(v4u, v); u ^= 0x80008000u; return __builtin_bit_cast(bf16x8, u); }
__device__ __forceinline__ void fourier1_unit(const Ctx& C, int t2, int jh, const bf16x8 (&dc)[4], const bf16x8 (&ds)[4]) {
    LAS bf16* UT = (LAS bf16*)C.lds;
    const bf16* QK = WSP(bf16, WS_QKVF);
#pragma unroll
    for (int i = 0; i < 4; ++i) { const int ch = C.tid + 512 * i, t1 = ch >> 4, c8 = ch & 15;
        const v4u v = *(const v4u*)(QK + (size_t)(128 * t1 + t2) * NQKVF + FCOL + jh * 128 + c8 * 8);
#pragma unroll
        for (int e = 0; e < 4; ++e) { UT[(c8 * 8 + 2 * e) * 136 + t1] = (bf16)(v[e] & 0xffffu); UT[(c8 * 8 + 2 * e + 1) * 136 + t1] = (bf16)(v[e] >> 16); } }
    __syncthreads();
    const int fr = C.lane & 15, kg = C.lane >> 4;
    bf16* PB = WSP(bf16, WS_PB); bf16* QB = WSP(bf16, WS_QB);
#pragma unroll 1
    for (int nh = 0; nh < 2; ++nh) {
        f32x4 aC[4], aS[4];
#pragma unroll
        for (int nt = 0; nt < 4; ++nt) { aC[nt] = (f32x4){0.f, 0.f, 0.f, 0.f}; aS[nt] = (f32x4){0.f, 0.f, 0.f, 0.f}; }
#pragma unroll
        for (int ks = 0; ks < 4; ++ks)
#pragma unroll
            for (int nt = 0; nt < 4; ++nt) { const bf16x8 b = *(const LAS bf16x8*)(UT + (64 * nh + 16 * nt + fr) * 136 + 32 * ks + 8 * kg);
                aC[nt] = __builtin_amdgcn_mfma_f32_16x16x32_bf16(dc[ks], b, aC[nt], 0, 0, 0); aS[nt] = __builtin_amdgcn_mfma_f32_16x16x32_bf16(ds[ks], b, aS[nt], 0, 0, 0); }
#pragma unroll
        for (int rg = 0; rg < 4; ++rg) { const int k1 = 16 * C.wave + 4 * kg + rg; const float ph = (float)(k1 * t2) * (1.f / 16384.f);
            const float cp = __builtin_amdgcn_cosf(ph), sp = __builtin_amdgcn_sinf(ph); const size_t ro = ((size_t)k1 * 128 + t2) * 256 + jh * 128 + nh * 64 + fr;
#pragma unroll
            for (int nt = 0; nt < 4; ++nt) { const float sr = aC[nt][rg], ss = aS[nt][rg];
                PB[ro + 16 * nt] = (bf16)f2bf(sr * cp - ss * sp); QB[ro + 16 * nt] = (bf16)f2bf(sr * sp + ss * cp); } }
    }
    __syncthreads();
}
constexpr int F2_CT_OFF = 40960, F2_ST_OFF = 40960 + 9216;
__device__ __forceinline__ void fourier2_tables(const Ctx& C) {
    LAS bf16* CT = (LAS bf16*)(C.lds + F2_CT_OFF); LAS bf16* ST = (LAS bf16*)(C.lds + F2_ST_OFF);
    for (int i = C.tid; i < 4096; i += 512) { const int m = i >> 6, j = i & 63; const float f = (float)((m * j) & 63) * (1.f / 64.f);
        CT[m * 72 + j] = (bf16)f2bf(__builtin_amdgcn_cosf(f)); ST[m * 72 + j] = (bf16)f2bf(__builtin_amdgcn_sinf(f)); }
    __syncthreads();
}
__device__ __forceinline__ void fourier2_unit(const Ctx& C, int k1, int g, const bf16x8 (&dc)[4], const bf16x8 (&ds)[4]) {
    LAS bf16* PT = (LAS bf16*)C.lds; LAS bf16* QT = PT + 64 * 136;
    LAS bf16* XR = (LAS bf16*)C.lds; LAS bf16* XQ = XR + 128 * 72;
    const LAS bf16* CT = (const LAS bf16*)(C.lds + F2_CT_OFF); const LAS bf16* ST = (const LAS bf16*)(C.lds + F2_ST_OFF);
    const bf16* PB = WSP(bf16, WS_PB); const bf16* QB = WSP(bf16, WS_QB);
#pragma unroll
    for (int i = 0; i < 4; ++i) { const int ch = C.tid + 512 * i, mat = ch >> 10, r = ch & 1023, t2 = r >> 3, c8 = r & 7;
        const v4u v = *(const v4u*)((mat ? QB : PB) + ((size_t)k1 * 128 + t2) * 256 + g * 64 + c8 * 8); LAS bf16* dst = mat ? QT : PT;
#pragma unroll
        for (int e = 0; e < 4; ++e) { dst[(c8 * 8 + 2 * e) * 136 + t2] = (bf16)(v[e] & 0xffffu); dst[(c8 * 8 + 2 * e + 1) * 136 + t2] = (bf16)(v[e] >> 16); } }
    __syncthreads();
    const int fr = C.lane & 15, kg = C.lane >> 4;
    f32x4 xr[4], xq[4];
#pragma unroll
    for (int nt = 0; nt < 4; ++nt) { xr[nt] = (f32x4){0.f, 0.f, 0.f, 0.f}; xq[nt] = (f32x4){0.f, 0.f, 0.f, 0.f}; }
#pragma unroll
    for (int ks = 0; ks < 4; ++ks)
#pragma unroll
        for (int nt = 0; nt < 4; ++nt) { const bf16x8 bp = *(const LAS bf16x8*)(PT + (16 * nt + fr) * 136 + 32 * ks + 8 * kg), bq = *(const LAS bf16x8*)(QT + (16 * nt + fr) * 136 + 32 * ks + 8 * kg);
            xr[nt] = __builtin_amdgcn_mfma_f32_16x16x32_bf16(dc[ks], bp, xr[nt], 0, 0, 0); xr[nt] = __builtin_amdgcn_mfma_f32_16x16x32_bf16(ds[ks], neg8(bq), xr[nt], 0, 0, 0);
            xq[nt] = __builtin_amdgcn_mfma_f32_16x16x32_bf16(dc[ks], bq, xq[nt], 0, 0, 0); xq[nt] = __builtin_amdgcn_mfma_f32_16x16x32_bf16(ds[ks], bp, xq[nt], 0, 0, 0); }
    __syncthreads();
#pragma unroll
    for (int nt = 0; nt < 4; ++nt)
#pragma unroll
        for (int rg = 0; rg < 4; ++rg) { const int k2 = 16 * C.wave + 4 * kg + rg, j = 16 * nt + fr; XR[k2 * 72 + j] = (bf16)f2bf(xr[nt][rg]); XQ[k2 * 72 + j] = (bf16)f2bf(xq[nt][rg]); }
    __syncthreads();
    f32x4 o[4];
#pragma unroll
    for (int nt = 0; nt < 4; ++nt) o[nt] = (f32x4){0.f, 0.f, 0.f, 0.f};
#pragma unroll
    for (int ks = 0; ks < 2; ++ks) { const bf16x8 ar = *(const LAS bf16x8*)(XR + (16 * C.wave + fr) * 72 + 32 * ks + 8 * kg), aq = neg8(*(const LAS bf16x8*)(XQ + (16 * C.wave + fr) * 72 + 32 * ks + 8 * kg));
#pragma unroll
        for (int nt = 0; nt < 4; ++nt) { const bf16x8 bc = *(const LAS bf16x8*)(CT + (16 * nt + fr) * 72 + 32 * ks + 8 * kg), bs = *(const LAS bf16x8*)(ST + (16 * nt + fr) * 72 + 32 * ks + 8 * kg);
            o[nt] = __builtin_amdgcn_mfma_f32_16x16x32_bf16(ar, bc, o[nt], 0, 0, 0); o[nt] = __builtin_amdgcn_mfma_f32_16x16x32_bf16(aq, bs, o[nt], 0, 0, 0); } }
    bf16* MIX = WSP(bf16, WS_MIX);
#pragma unroll
    for (int nt = 0; nt < 4; ++nt)
#pragma unroll
        for (int rg = 0; rg < 4; ++rg) { const int k2 = 16 * C.wave + 4 * kg + rg; MIX[(size_t)(k1 + 128 * k2) * 1024 + 768 + 64 * g + 16 * nt + fr] = (bf16)f2bf(o[nt][rg] * (1.f / 1024.f)); }
    __syncthreads();
}

__device__ __forceinline__ void p11_conv_gate(const Ctx& C) {
    const bf16* B = WSP(bf16, WS_BCU); bf16* V = WSP(bf16, WS_VB); const float* cw = C.in[15];
    const int nthr = C.G * 512;
    for (int idx = C.blk * 512 + C.tid; idx < SEQ * 128; idx += nthr) {
        const int t = idx >> 7, c0 = (idx & 127) * 8;
        const bf16* row = B + (size_t)t * 3072 + c0;
        float cu[3][8];
#pragma unroll
        for (int d = 0; d < 3; ++d) { const int tt = t + d - 1; const bool ok = (tt >= 0) && (tt < SEQ);
            f32x4 c_lo = {0.f, 0.f, 0.f, 0.f}, c_hi = c_lo, u_lo = c_lo, u_hi = c_lo;
            if (ok) { const bf16* r2 = B + (size_t)tt * 3072 + c0; c_lo = ld_bf4(r2 + 1024); c_hi = ld_bf4(r2 + 1028); u_lo = ld_bf4(r2 + 2048); u_hi = ld_bf4(r2 + 2052); }
#pragma unroll
            for (int e = 0; e < 4; ++e) { cu[d][e] = c_lo[e] * u_lo[e]; cu[d][4 + e] = c_hi[e] * u_hi[e]; } }
        const f32x4 b_lo = ld_bf4(row), b_hi = ld_bf4(row + 4);
        f32x4 o_lo, o_hi;
#pragma unroll
        for (int e = 0; e < 4; ++e) {
            o_lo[e] = b_lo[e] * (cw[c0 + e] * cu[0][e] + cw[1024 + c0 + e] * cu[1][e] + cw[2048 + c0 + e] * cu[2][e]);
            o_hi[e] = b_hi[e] * (cw[c0 + 4 + e] * cu[0][4 + e] + cw[1024 + c0 + 4 + e] * cu[1][4 + e] + cw[2048 + c0 + 4 + e] * cu[2][4 + e]); }
        st_bf4(V + (size_t)t * 1024 + c0, o_lo); st_bf4(V + (size_t)t * 1024 + c0 + 4, o_hi);
    }
}

__device__ __forceinline__ void p14_gather(const Ctx& C) {
    LAS unsigned* T = (LAS unsigned*)C.lds;
    if (C.tid < 24) T[C.tid] = 0u;
    __syncthreads();
    const int* bc = SMP(int, SM_BLKCNT);
    for (int idx = C.tid; idx < C.G * 8; idx += 512) { const int b = idx >> 3, e = idx & 7; const unsigned v = (unsigned)bc[idx];
        atomicAdd((unsigned*)&T[e], v); if (b < C.blk) atomicAdd((unsigned*)&T[8 + e], v); }
    __syncthreads();
    if (C.tid == 0) { unsigned off = 0, tile = 0; int* te = SMP(int, SM_TILEE);
        for (int e = 0; e < 8; ++e) { T[16 + e] = off + T[8 + e]; const unsigned nt = (T[e] + 255u) >> 8;
            if (C.blk == 0) for (unsigned q = 0; q < nt; ++q) te[tile + q] = e;
            tile += nt; off += nt * 256u; }
        if (C.blk == 0) te[MOE_TILES_MAX] = (int)tile; }
    __syncthreads();
    const int rows_per_blk = SEQ / C.G, ent_per_wave = 2 * rows_per_blk / NWAVES;
    const unsigned char* H = WSP(unsigned char, WS_H2); unsigned char* HP = WSP(unsigned char, WS_HPERM);
    for (int i = 0; i < ent_per_wave; ++i) { const int ent = C.wave * ent_per_wave + i, gent = C.blk * 2 * rows_per_blk + ent, m = gent >> 1;
        const int e = SMP(int, SM_TOKE)[gent], rk = SMP(int, SM_TOKR)[gent]; const int pos = (int)T[16 + e] + rk;
        const v4u* src = (const v4u*)(H + (size_t)m * 1024); v4u* dst = (v4u*)(HP + (size_t)pos * 1024);
        dst[C.lane] = src[C.lane];
        if (C.lane == 0) SMP(int, SM_TOKP)[gent] = pos; }
    __syncthreads();
}

struct MoeOrder {
    pg8::StaticOrder so; int t0, bstride, a_rel; const LAS int* te;
    __device__ __forceinline__ void init(int t0_, int ntiles, int nN, int bstride_, int a_rel_, const LAS int* te_, int G, int c) {
        t0 = t0_; bstride = bstride_; a_rel = a_rel_; te = te_; so.nM = ntiles; so.nN = nN; so.nwg = ntiles * nN; so.G = G; so.c = c; }
    __device__ __forceinline__ bool next(int i, pg8::Unit& u) const {
        if (!so.next(i, u)) return false;
        const int loc = u.pm, tile = t0 + loc, e = __builtin_amdgcn_readfirstlane(te[tile]);
        u.pb = e * bstride + u.pn;
        if (a_rel) { u.pa = loc; u.pm = tile; } else { u.pa = tile; u.pm = loc; }
        return true; }
    __device__ __forceinline__ void a_ready(const pg8::Unit&) const {}
    __device__ __forceinline__ void done(const pg8::Unit&) const {}
};

struct Args { const float* in[21]; float* out; unsigned char* ws; int ph_lo, ph_hi; };
__global__ void __launch_bounds__(NWAVES * 64, 2) mk_fwd(Args args) {
    extern __shared__ __attribute__((aligned(16))) unsigned char lds[];
    Ctx C;
    C.lds = (LAS unsigned char*)lds;
    C.tid = threadIdx.x; C.lane = C.tid & 63; C.wave = __builtin_amdgcn_readfirstlane(C.tid >> 6);
    C.G = gridDim.x; C.blk = blockIdx.x; C.vcu = (C.G % 8 == 0) ? (C.blk % 8) * (C.G / 8) + C.blk / 8 : C.blk;
#pragma unroll
    for (int i = 0; i < 21; ++i) C.in[i] = args.in[i];
    C.out = args.out; C.ws = args.ws;
    volatile LAS unsigned* LCTL = (volatile LAS unsigned*)(C.lds + LDSCTL_OFF);
    for (int u = C.tid; u < (LDS_BYTES - LDSCTL_OFF) / 4; u += NWAVES * 64) LCTL[u] = 0u;
    __syncthreads();
    const int lo = args.ph_lo, hi = args.ph_hi;
    const bool use_bar = (hi - lo) > 1;
    XcdBarrier bar; bar.bar = (unsigned*)(C.ws + WS_CTL) + CW_BAR; bar.x = 0; bar.st = LCTL;
    if (use_bar) bar = xcd_barrier_post((unsigned*)(C.ws + WS_CTL) + CW_BAR, LCTL);
#define IN(k) (lo <= (k) && (k) < hi)
#define SEAM(k) do { if (IN(k) && IN((k) + 1)) xcd_barrier(bar); } while (0)
    const float* mod0 = SMP(float, SM_MOD0); const float* mod1 = SMP(float, SM_MOD1); const float* nw = C.in[6];
    LAS unsigned char* ring = C.lds + RING_OFF;

#ifndef REP_P0
#define REP_P0 1
#endif
#ifndef REP_ATT
#define REP_ATT 1
#endif
#ifndef REP_MOE
#define REP_MOE 1
#endif
#ifndef REP_THIN
#define REP_THIN 1
#endif
#ifndef REP_GEMM
#define REP_GEMM 1
#endif
    if (IN(0)) { for (int rp = 0; rp < REP_P0; ++rp) { p0_prologue(C); __syncthreads(); } } SEAM(0);
    if (IN(1)) { for (int rp = 0; rp < REP_THIN; ++rp) p1_modulate(C); } SEAM(1);
    if (IN(2)) {
        pg8::Gemm g{WSP(bf16, WS_H), WSP(bf16, WS_WIN0), MROWS, NQKVF, 1024}; pg8::StaticOrder S; S.init(MROWS, NQKVF, C.G, C.blk);
        pg8::EpiBf16<0> E{WSP(bf16, WS_QKVF), NQKVF, nullptr, 0, 0, 1.f};
        for (int rp = 0; rp < REP_GEMM; ++rp) pg8::gemm_phase<pg8::EpiBf16<0>, pg8::StaticOrder, true, true>(ring, g, S, E);
    } SEAM(2);
    if (IN(3)) {
        p3_qknorm_rope(C);
        bf16x8 dc[4], ds[4]; dft128_frags(C.wave, C.lane & 15, C.lane >> 4, dc, ds);
        for (int u = C.vcu; u < 256; u += C.G) fourier1_unit(C, u >> 1, u & 1, dc, ds);
    } SEAM(3);
    if (IN(4)) {
        { bf16x8 dc[4], ds[4]; dft128_frags(C.wave, C.lane & 15, C.lane >> 4, dc, ds);
          fourier2_tables(C);
          for (int u = C.vcu; u < 512; u += C.G) fourier2_unit(C, u >> 2, u & 3, dc, ds); }
        __syncthreads();
        const attn_body::AttnTensors AT{(const attn_body::bf16*)WSP(bf16, WS_QKVF), (const attn_body::bf16*)(WSP(bf16, WS_QKVF) + KCOL), (const attn_body::bf16*)(WSP(bf16, WS_QKVF) + VCOL), (attn_body::bf16*)WSP(bf16, WS_MIX)};
        const attn_body::GqaOrder S(C.G, C.blk);
        for (int rp = 0; rp < REP_ATT; ++rp) attn_body::attn_phase<attn_body::GqaOrder>((char*)lds + RING_OFF, AT, S);
    } SEAM(4);
    if (IN(5)) {
        pg8::Gemm g{WSP(bf16, WS_MIX), WSP(bf16, WS_WOUT0), SEQ, 1024, 1024}; pg8::StaticOrder S; S.init(SEQ, 1024, C.G, C.blk);
        pg8::EpiBf16<0> E{WSP(bf16, WS_Y), 1024, nullptr, 0, 0, 1.f};
        for (int rp = 0; rp < REP_GEMM; ++rp) pg8::gemm_phase<pg8::EpiBf16<0>, pg8::StaticOrder, true, true>(ring, g, S, E);
    } SEAM(5);
    if (IN(6)) { for (int rp = 0; rp < REP_THIN; ++rp) post_rows<1>(C, mod0 + 2048, nw + 1024, nw + 2048, mod0 + 4096, mod0 + 3072, C.in[0], WSP(bf16, WS_Y), C.out, WSP(bf16, WS_H)); } SEAM(6);
    if (IN(7)) {
        pg8::Gemm g{WSP(bf16, WS_H), WSP(bf16, WS_WGU0), SEQ, 2 * DFF, 1024}; pg8::StaticOrder S; S.init(SEQ, 2 * DFF, C.G, C.blk);
        pg8::EpiSwiGLU E{WSP(bf16, WS_ACT0), DFF};
        for (int rp = 0; rp < REP_GEMM; ++rp) pg8::gemm_phase<pg8::EpiSwiGLU, pg8::StaticOrder, true, true>(ring, g, S, E);
    } SEAM(7);
    if (IN(8)) {
        pg8::Gemm g{WSP(bf16, WS_ACT0), WSP(bf16, WS_WDN0), SEQ, 1024, DFF}; pg8::StaticOrder S; S.init(SEQ, 1024, C.G, C.blk);
        pg8::EpiBf16<0> E{WSP(bf16, WS_Y), 1024, nullptr, 0, 0, 1.f};
        for (int rp = 0; rp < REP_GEMM; ++rp) pg8::gemm_phase<pg8::EpiBf16<0>, pg8::StaticOrder, true, true>(ring, g, S, E);
    } SEAM(8);
    if (IN(9)) { post_rows<1>(C, mod0 + 5120, nw + 3072, nw + 4096, mod1 + 1024, mod1, C.out, WSP(bf16, WS_Y), C.out, WSP(bf16, WS_H)); } SEAM(9);
    if (IN(10)) {
        pg8::Gemm g{WSP(bf16, WS_H), WSP(bf16, WS_WIN1), SEQ, 3072, 1024}; pg8::StaticOrder S; S.init(SEQ, 3072, C.G, C.blk);
        pg8::EpiBf16<0> E{WSP(bf16, WS_BCU), 3072, nullptr, 0, 0, 1.f};
        for (int rp = 0; rp < REP_GEMM; ++rp) pg8::gemm_phase<pg8::EpiBf16<0>, pg8::StaticOrder, true, true>(ring, g, S, E);
    } SEAM(10);
    if (IN(11)) { for (int rp = 0; rp < REP_THIN; ++rp) p11_conv_gate(C); } SEAM(11);
    if (IN(12)) {
        pg8::Gemm g{WSP(bf16, WS_VB), WSP(bf16, WS_WOUT1), SEQ, 1024, 1024}; pg8::StaticOrder S; S.init(SEQ, 1024, C.G, C.blk);
        pg8::EpiBf16<0> E{WSP(bf16, WS_Y), 1024, nullptr, 0, 0, 1.f};
        for (int rp = 0; rp < REP_GEMM; ++rp) pg8::gemm_phase<pg8::EpiBf16<0>, pg8::StaticOrder, true, true>(ring, g, S, E);
    } SEAM(12);
    if (IN(13)) { post_rows<2>(C, mod1 + 2048, nw + 4096 + 1024, nw + 4096 + 2048, mod1 + 4096, mod1 + 3072, C.out, WSP(bf16, WS_Y), C.out, WSP(bf16, WS_H2)); } SEAM(13);
    if (IN(14)) { for (int rp = 0; rp < REP_THIN; ++rp) p14_gather(C); } SEAM(14);
    if (IN(15)) {
        LAS int* te = (LAS int*)(C.lds + LDSCTL_OFF + 64); const int* teg = SMP(int, SM_TILEE);
        for (int i = C.tid; i <= MOE_TILES_MAX; i += 512) te[i] = teg[i];
        __syncthreads();
        int np = __builtin_amdgcn_readfirstlane(te[MOE_TILES_MAX]); np = np < 0 ? 0 : (np > MOE_TILES_MAX ? MOE_TILES_MAX : np);
        pg8::Gemm g{WSP(bf16, WS_HPERM), WSP(bf16, WS_WEGU), 0, 2 * DEXP, 1024 / 2}; MoeOrder S;     S.init(0, np, 2 * DEXP / 256, 2 * DEXP / 256, 0, te, C.G, C.blk);
        pg8::EpiSwiGLU8 E{WSP(unsigned char, WS_ACT1), DEXP, 1.f / WSCALE_GU};
        pg8::gemm_phase<pg8::EpiSwiGLU8, MoeOrder, true, true, true>(ring, g, S, E);
    } SEAM(15);
    if (IN(16)) {
        LAS int* te = (LAS int*)(C.lds + LDSCTL_OFF + 64); const int* teg = SMP(int, SM_TILEE);
        for (int i = C.tid; i <= MOE_TILES_MAX; i += 512) te[i] = teg[i];
        __syncthreads();
        int np = __builtin_amdgcn_readfirstlane(te[MOE_TILES_MAX]); np = np < 0 ? 0 : (np > MOE_TILES_MAX ? MOE_TILES_MAX : np);
        pg8::Gemm g{WSP(bf16, WS_ACT1), WSP(bf16, WS_WEDN), 0, 1024, DEXP / 2}; MoeOrder S; S.init(0, np, 4, 4, 1, te, C.G, C.blk);
        pg8::EpiBf16<0> E{WSP(bf16, WS_YP), 1024, nullptr, 1024, 0, 1.f / WSCALE_DN};
        pg8::gemm_phase<pg8::EpiBf16<0>, MoeOrder, true, true, true>(ring, g, S, E);
    } SEAM(16);
    if (IN(17)) { post_rows<3>(C, mod1 + 5120, nw + 4096 + 3072, nw, mod1, mod1, C.out, nullptr, C.out, nullptr); }
#undef IN
#undef SEAM
}

extern "C" void kernel_launch(void* const* d_in, const int* in_sizes, int n_in, void* d_out, int out_size, void* d_ws, size_t ws_size, hipStream_t stream) {
    static int grid = 0;
    if (grid == 0) {
        if (n_in != 21 || in_sizes[0] != SEQ * DMODEL || out_size != SEQ * DMODEL || ws_size < WS_END) {
            fprintf(stderr, "kernel_launch: unexpected problem (n_in %d, in0 %d, out %d, ws %zu, need %zu); nothing launched\n", n_in, n_in > 0 ? in_sizes[0] : -1, out_size, ws_size, (size_t)WS_END); grid = -1; return; }
        int dev = 0, cus = 0;
        if (hipGetDevice(&dev) != hipSuccess || hipDeviceGetAttribute(&cus, hipDeviceAttributeMultiprocessorCount, dev) != hipSuccess) { grid = -1; return; }
        if (hipFuncSetAttribute((const void*)mk_fwd, hipFuncAttributeMaxDynamicSharedMemorySize, LDS_BYTES) != hipSuccess) { fprintf(stderr, "kernel_launch: hipFuncSetAttribute failed\n"); grid = -1; return; }
        int per_cu = 0;
        if (hipOccupancyMaxActiveBlocksPerMultiprocessor(&per_cu, (const void*)mk_fwd, NWAVES * 64, LDS_BYTES) != hipSuccess || per_cu < 1) fprintf(stderr, "kernel_launch: occupancy query reports %d\n", per_cu);
        (void)hipGetLastError();
        if (cus != 256) { fprintf(stderr, "kernel_launch: built for 256 CUs, device has %d; nothing launched\n", cus); grid = -1; return; }
        grid = cus;
    }
    if (grid < 0) return;
    if (hipMemsetAsync((char*)d_ws + WS_CTL, 0, CTL_ZERO_BYTES, stream) != hipSuccess) return;
    Args a{};
    for (int i = 0; i < 21; ++i) a.in[i] = (const float*)d_in[i];
    a.out = (float*)d_out; a.ws = (unsigned char*)d_ws;
#if MK_N_LAUNCHES == 1
    a.ph_lo = 0; a.ph_hi = NPH;
    hipLaunchKernelGGL(mk_fwd, dim3(grid), dim3(NWAVES * 64), LDS_BYTES, stream, a);
#else
    for (int li = 0; li < NPH; ++li) { a.ph_lo = li; a.ph_hi = li + 1; hipLaunchKernelGGL(mk_fwd, dim3(grid), dim3(NWAVES * 64), LDS_BYTES, stream, a); }
#endif
}
```

```cpp
#include <hip/hip_runtime.h>
#include <cstdio>
#include <cstdint>
namespace pg8 {
#define PG8_LAS __attribute__((address_space(3)))
typedef unsigned short bf16_t;
typedef short bf16x8 __attribute__((ext_vector_type(8)));
typedef float f32x4 __attribute__((ext_vector_type(4)));
typedef unsigned u32x4 __attribute__((ext_vector_type(4)));
constexpr int BM = 256, BK = 64, HALF = 128, HTB = HALF * BK * 2  , STAGE_BYTES = 8 * HTB, NXCD = 8, WGM = 8;

__host__ __device__ __forceinline__ int lds_byte(int r, int c) { const int st = (r >> 4) * 2 + (c >> 5), rr = r & 15, cc = c & 31, ob = rr * 64 + cc * 2; return st * 1024 + (ob ^ (((ob >> 9) & 1) << 5)); }
__host__ __device__ __forceinline__ void stage_rc(int b, int& R, int& C) { const int st = b / 1024, sb = b % 1024, swz = sb ^ (((sb >> 9) & 1) << 5); R = (st >> 1) * 16 + swz / 64; C = (st & 1) * 32 + (swz % 64) / 2; }
__host__ __device__ __forceinline__ int perm32(int rho) { const int n = rho >> 4, i = rho & 15; return 8 * (i >> 2) + 4 * n + (i & 3); }

struct Unit { int pm, pn, pa, pb; };
struct Gemm { const bf16_t* A; const bf16_t* Bt; int M, N, K; };

struct StaticOrder {
    int nM, nN, nwg, G, c;
    __host__ __device__ void init(int M, int N, int G_, int c_) { nM = M / BM; nN = N / BM; nwg = nM * nN; G = G_; c = c_; }
    __host__ __device__ bool next(int i, Unit& u) const {
        const long L = (long)i * G + c; if (L >= nwg) return false;
        int wgid = (int)L; { const int q = nwg / NXCD, r = nwg % NXCD, xcd = wgid % NXCD, off = wgid / NXCD; wgid = (xcd < r ? xcd * (q + 1) : r * (q + 1) + (xcd - r) * q) + off; }
        const int nig = WGM * nN, gid = wgid / nig, fm = gid * WGM, gsz = (nM - fm) < WGM ? (nM - fm) : WGM;
        u.pm = fm + ((wgid % nig) % gsz); u.pn = (wgid % nig) / gsz; u.pa = u.pm; u.pb = u.pn; return true;
    }
    __device__ __forceinline__ void a_ready(const Unit&) const {}
    __device__ __forceinline__ void done(const Unit&) const {}
};

__device__ __forceinline__ unsigned cvt_pk_bf16(float lo, float hi) { unsigned r; asm volatile("v_cvt_pk_bf16_f32 %0, %1, %2" : "=v"(r) : "v"(lo), "v"(hi)); return r; }
typedef float f32x2 __attribute__((ext_vector_type(2)));
__device__ __forceinline__ f32x2 gelu_pk(f32x2 v) {
    const f32x2 av = __builtin_elementwise_abs(v), d = av * 0.2316418882f + 1.0f;
    f32x2 t; t.x = __builtin_amdgcn_rcpf(d.x); t.y = __builtin_amdgcn_rcpf(d.y);
    f32x2 q = t * 0.5307027145f + (-0.7265760135f); q = q * t + 0.7107068705f; q = q * t + (-0.142248368f); q = q * t + 0.127414796f; q = q * t;
    const f32x2 s = (v * v) * (-0.72134752044f);
    f32x2 e; e.x = __builtin_amdgcn_exp2f(s.x); e.y = __builtin_amdgcn_exp2f(s.y);
    const f32x2 m = v * (q * e), r = v - m;
    f32x2 o; o.x = v.x < 0.f ? m.x : r.x; o.y = v.y < 0.f ? m.y : r.y; return o;
}

template <int ACT  > struct EpiBf16 {
    static constexpr bool PERM = true, AFTER_DRAIN = false; static_assert(ACT == 0 || ACT == 1, "EpiBf16: ACT is 0 (none) or 1 (gelu_pk)");
    bf16_t* O; int ldc; const float* bias; int split_cols; size_t split_stride; float scale0;
    __device__ __forceinline__ void operator()(const f32x4 (&acc)[2][2][4][2], const Unit& u, int wr, int wc, int fr, int fq) const {
        const int row0 = u.pm * BM + wr * 64 + fr; int colt = u.pn * BM; bf16_t* base = O;
        float sc = 1.f; if (split_cols) { const int t = colt / split_cols; base += (size_t)t * split_stride; colt -= t * split_cols; if (t == 0) sc = scale0; }
        const int col0 = colt + wc * 32 + 8 * fq, bcol0 = u.pn * BM + wc * 32 + 8 * fq;
        f32x4 bv[2][2];
#pragma unroll
        for (int bj = 0; bj < 2; ++bj)
#pragma unroll
            for (int n = 0; n < 2; ++n) bv[bj][n] = bias ? *(const f32x4*)(bias + bcol0 + bj * HALF + 4 * n) : (f32x4){0.f, 0.f, 0.f, 0.f};
#pragma unroll
        for (int ai = 0; ai < 2; ++ai)
#pragma unroll
            for (int m = 0; m < 4; ++m) { bf16_t* rowp = base + (size_t)(row0 + ai * HALF + m * 16) * ldc + col0;
#pragma unroll
                for (int bj = 0; bj < 2; ++bj) { f32x4 v0 = acc[ai][bj][m][0] + bv[bj][0], v1 = acc[ai][bj][m][1] + bv[bj][1];
                    if (ACT == 1) { f32x2 a = gelu_pk((f32x2){v0[0], v0[1]}), b = gelu_pk((f32x2){v0[2], v0[3]}), c = gelu_pk((f32x2){v1[0], v1[1]}), d = gelu_pk((f32x2){v1[2], v1[3]});
                        v0 = (f32x4){a.x, a.y, b.x, b.y}; v1 = (f32x4){c.x, c.y, d.x, d.y}; }
                    v0 = v0 * sc; v1 = v1 * sc; u32x4 w; w.x = cvt_pk_bf16(v0[0], v0[1]); w.y = cvt_pk_bf16(v0[2], v0[3]); w.z = cvt_pk_bf16(v1[0], v1[1]); w.w = cvt_pk_bf16(v1[2], v1[3]);
                    *(u32x4*)(rowp + bj * HALF) = w; } }
    }
};

typedef int v8i_t __attribute__((ext_vector_type(8))); typedef int v4i_t __attribute__((ext_vector_type(4)));
__device__ __forceinline__ v8i_t cat8(bf16x8 lo, bf16x8 hi) { const v4i_t a = __builtin_bit_cast(v4i_t, lo), b = __builtin_bit_cast(v4i_t, hi); return __builtin_shufflevector(a, b, 0, 1, 2, 3, 4, 5, 6, 7); }
__device__ __forceinline__ void mfma_f8(f32x4& acc, const v8i_t& a, const v8i_t& b) { asm volatile("v_mfma_f32_16x16x128_f8f6f4 %0, %1, %2, %0" : "+v"(acc) : "v"(a), "v"(b)); }
__device__ __forceinline__ float clamp448(float x) { return __builtin_fminf(__builtin_fmaxf(x, -448.f), 448.f); }
struct EpiSwiGLU8 {
    static constexpr bool PERM = true, AFTER_DRAIN = false;
    unsigned char* O; int ldc; float ds;
    __device__ __forceinline__ void operator()(const f32x4 (&acc)[2][2][4][2], const Unit& u, int wr, int wc, int fr, int fq) const {
        const int row0 = u.pm * BM + wr * 64 + fr; const int col0 = u.pn * HALF + wc * 32 + 8 * fq;
#pragma unroll
        for (int ai = 0; ai < 2; ++ai)
#pragma unroll
            for (int m = 0; m < 4; ++m) { unsigned char* rowp = O + (size_t)(row0 + ai * HALF + m * 16) * ldc + col0;
                const f32x4 g0 = acc[ai][0][m][0] * ds, g1 = acc[ai][0][m][1] * ds, u0 = acc[ai][1][m][0] * ds, u1 = acc[ai][1][m][1] * ds;
                f32x4 r0, r1;
#pragma unroll
                for (int e = 0; e < 4; ++e) {
                    r0[e] = clamp448(g0[e] * __builtin_amdgcn_rcpf(1.0f + __builtin_amdgcn_exp2f(-1.4426950408889634f * g0[e])) * u0[e]);
                    r1[e] = clamp448(g1[e] * __builtin_amdgcn_rcpf(1.0f + __builtin_amdgcn_exp2f(-1.4426950408889634f * g1[e])) * u1[e]); }
                int w0 = 0, w1 = 0;
                w0 = __builtin_amdgcn_cvt_pk_fp8_f32(r0[0], r0[1], w0, false); w0 = __builtin_amdgcn_cvt_pk_fp8_f32(r0[2], r0[3], w0, true);
                w1 = __builtin_amdgcn_cvt_pk_fp8_f32(r1[0], r1[1], w1, false); w1 = __builtin_amdgcn_cvt_pk_fp8_f32(r1[2], r1[3], w1, true);
                typedef int v2i_t __attribute__((ext_vector_type(2))); *(v2i_t*)rowp = (v2i_t){w0, w1}; }
    }
};

struct EpiSwiGLU {
    static constexpr bool PERM = true, AFTER_DRAIN = false;
    bf16_t* O; int ldc;
    __device__ __forceinline__ void operator()(const f32x4 (&acc)[2][2][4][2], const Unit& u, int wr, int wc, int fr, int fq) const {
        const int row0 = u.pm * BM + wr * 64 + fr; const int col0 = u.pn * HALF + wc * 32 + 8 * fq;
#pragma unroll
        for (int ai = 0; ai < 2; ++ai)
#pragma unroll
            for (int m = 0; m < 4; ++m) { bf16_t* rowp = O + (size_t)(row0 + ai * HALF + m * 16) * ldc + col0;
                const f32x4 g0 = acc[ai][0][m][0], g1 = acc[ai][0][m][1], u0 = acc[ai][1][m][0], u1 = acc[ai][1][m][1];
                f32x4 r0, r1;
#pragma unroll
                for (int e = 0; e < 4; ++e) {
                    r0[e] = g0[e] * __builtin_amdgcn_rcpf(1.0f + __builtin_amdgcn_exp2f(-1.4426950408889634f * g0[e])) * u0[e];
                    r1[e] = g1[e] * __builtin_amdgcn_rcpf(1.0f + __builtin_amdgcn_exp2f(-1.4426950408889634f * g1[e])) * u1[e]; }
                u32x4 w; w.x = cvt_pk_bf16(r0[0], r0[1]); w.y = cvt_pk_bf16(r0[2], r0[3]); w.z = cvt_pk_bf16(r1[0], r1[1]); w.w = cvt_pk_bf16(r1[2], r1[3]);
                *(u32x4*)rowp = w; }
    }
};

template <class Epi, class Sched, bool ALIGN_EPI = false, bool SP2 = false, bool F8 = false>
__device__ __forceinline__ void gemm_phase(PG8_LAS unsigned char* lds, const Gemm g, const Sched& S, const Epi& E) {
    const int tid = threadIdx.x, wid = __builtin_amdgcn_readfirstlane(tid >> 6), lane = tid & 63, wr = wid >> 2, wc = wid & 3, fr = lane & 15, fq = lane >> 4;
    const int K = g.K, nt = K / BK;
    unsigned voffA[2], voffB[2];
#pragma unroll
    for (int i = 0; i < 2; ++i) { int R, C; stage_rc(tid * 16 + i * 8192, R, C); const int Rb = Epi::PERM ? ((R & ~31) + perm32(R & 31)) : R;
        voffA[i] = (unsigned)(R * K + C) * 2u; voffB[i] = (unsigned)(Rb * K + C) * 2u; }
    const size_t kstep = (size_t)(BK * 2);
    const size_t hstep = (size_t)HALF * K * 2;
    const size_t tstep = 2 * hstep;
    const unsigned ldsw = (unsigned)wid * 1024u;
    const int aoff = lds_byte(wr * 64 + fr, fq * 8), boff = lds_byte(wc * 32 + fr, fq * 8);
#define PG8_SA(b, h) (((b) * 2 + (h)) * HTB)
#define PG8_SB(b, h) ((4 + (b) * 2 + (h)) * HTB)
#define PG8_STAGE(bufoff, gbase, voff) do { _Pragma("unroll") for (int _i = 0; _i < 2; ++_i) \
        __builtin_amdgcn_global_load_lds((const unsigned*)((const char*)(gbase) + (voff)[_i]), (PG8_LAS unsigned*)(lds + (bufoff) + ldsw + _i * 8192), 16, 0, 0); } while (0)
#define PG8_LDA(dst, b, h) do { if constexpr (F8) { _Pragma("unroll") for (int m = 0; m < 4; ++m) { dst##8[m].lo = *(const PG8_LAS v4i_t*)(lds + PG8_SA(b, h) + aoff + m * 2048); dst##8[m].hi = *(const PG8_LAS v4i_t*)(lds + PG8_SA(b, h) + aoff + m * 2048 + 1024); } } \
        else { _Pragma("unroll") for (int m = 0; m < 4; ++m) _Pragma("unroll") for (int k = 0; k < 2; ++k) dst[m][k] = *(const PG8_LAS bf16x8*)(lds + PG8_SA(b, h) + aoff + m * 2048 + k * 1024); } } while (0)
#define PG8_LDB(dst, b, h) do { if constexpr (F8) { _Pragma("unroll") for (int n = 0; n < 2; ++n) { dst##8[n].lo = *(const PG8_LAS v4i_t*)(lds + PG8_SB(b, h) + boff + n * 2048); dst##8[n].hi = *(const PG8_LAS v4i_t*)(lds + PG8_SB(b, h) + boff + n * 2048 + 1024); } } \
        else { _Pragma("unroll") for (int n = 0; n < 2; ++n) _Pragma("unroll") for (int k = 0; k < 2; ++k) dst[n][k] = *(const PG8_LAS bf16x8*)(lds + PG8_SB(b, h) + boff + n * 2048 + k * 1024); } } while (0)
#define PG8_MMA(ai, bj, At, Bt) do { __builtin_amdgcn_s_setprio(1); _Pragma("unroll") for (int m = 0; m < 4; ++m) _Pragma("unroll") for (int n = 0; n < 2; ++n) { \
        if constexpr (F8) mfma_f8(acc[ai][bj][m][n], Bt##8[n], At##8[m]); \
        else { _Pragma("unroll") for (int k = 0; k < 2; ++k) acc[ai][bj][m][n] = __builtin_amdgcn_mfma_f32_16x16x32_bf16(Bt[n][k], At[m][k], acc[ai][bj][m][n], 0, 0, 0); } } __builtin_amdgcn_s_setprio(0); } while (0)
#define PG8_WAIT_V(n) asm volatile("s_waitcnt vmcnt(" #n ")" ::: "memory")
#define PG8_WAIT_L(n) asm volatile("s_waitcnt lgkmcnt(" #n ")" ::: "memory")
#define PG8_BAR __builtin_amdgcn_s_barrier()
#define PG8_SCHED __builtin_amdgcn_sched_barrier(0)
    Unit cur, nxt; int ui = 0;
    if (!S.next(0, cur)) return;
    f32x4 acc[2][2][4][2];
#pragma unroll
    for (int a = 0; a < 2; ++a)
#pragma unroll
        for (int b = 0; b < 2; ++b)
#pragma unroll
            for (int m = 0; m < 4; ++m)
#pragma unroll
                for (int n = 0; n < 2; ++n) acc[a][b][m][n] = (f32x4){0.f, 0.f, 0.f, 0.f};
    bf16x8 At[4][2], B0[2][2], B1[2][2]; v8i_t At8[4], B08[2], B18[2];
    const char* cA = (const char*)g.A + (size_t)cur.pa * tstep; const char* cB = (const char*)g.Bt + (size_t)cur.pb * tstep;
    S.a_ready(cur);
    if constexpr (SP2) {
        PG8_STAGE(PG8_SB(0, 0), cB, voffB); PG8_STAGE(PG8_SB(0, 1), cB + hstep, voffB); PG8_STAGE(PG8_SA(0, 0), cA, voffA); PG8_STAGE(PG8_SA(0, 1), cA + hstep, voffA);
        if (wr == 1) PG8_BAR;
        PG8_WAIT_V(2); PG8_BAR;
        PG8_STAGE(PG8_SB(1, 0), cB + kstep, voffB); PG8_STAGE(PG8_SA(1, 0), cA + kstep, voffA); PG8_STAGE(PG8_SB(1, 1), cB + hstep + kstep, voffB);
        PG8_WAIT_V(6); PG8_BAR;
    } else {
        PG8_STAGE(PG8_SB(0, 0), cB, voffB); PG8_STAGE(PG8_SA(0, 0), cA, voffA); PG8_STAGE(PG8_SB(0, 1), cB + hstep, voffB); PG8_STAGE(PG8_SA(0, 1), cA + hstep, voffA);
        if (wr == 1) PG8_BAR;
        PG8_WAIT_V(4); PG8_BAR;
        PG8_STAGE(PG8_SB(1, 0), cB + kstep, voffB); PG8_STAGE(PG8_SA(1, 0), cA + kstep, voffA); PG8_STAGE(PG8_SB(1, 1), cB + hstep + kstep, voffB);
        PG8_WAIT_V(6); PG8_BAR;
    }
    for (;;) {
        const bool has_next = S.next(ui + 1, nxt);
        const char* nA = has_next ? (const char*)g.A + (size_t)nxt.pa * tstep : cA; const char* nB = has_next ? (const char*)g.Bt + (size_t)nxt.pb * tstep : cB;
        for (int t = 0; t < nt; t += 2) {
            const bool last = (t == nt - 2);
            const char* a1 = cA + (size_t)(t + 1) * kstep;
            const char* a2 = last ? nA : cA + (size_t)(t + 2) * kstep; const char* b2 = last ? nB : cB + (size_t)(t + 2) * kstep;
            const char* a3 = a2 + kstep; const char* b3 = b2 + kstep;
            if (last && has_next) S.a_ready(nxt);
            if constexpr (SP2) {
            PG8_LDB(B0, 0, 0); PG8_LDB(B1, 0, 1); PG8_SCHED; PG8_LDA(At, 0, 0); PG8_STAGE(PG8_SA(1, 1), a1 + hstep, voffA);
            PG8_WAIT_V(8); PG8_WAIT_L(0); PG8_BAR; PG8_MMA(0, 0, At, B0); PG8_MMA(0, 1, At, B1); PG8_BAR; PG8_SCHED;
            PG8_LDA(At, 0, 1); PG8_STAGE(PG8_SB(0, 0), b2, voffB); PG8_STAGE(PG8_SB(0, 1), b2 + hstep, voffB); PG8_STAGE(PG8_SA(0, 0), a2, voffA);
            PG8_WAIT_V(8); PG8_WAIT_L(0); PG8_BAR; PG8_MMA(1, 0, At, B0); PG8_MMA(1, 1, At, B1); PG8_BAR; PG8_SCHED;
            PG8_LDB(B0, 1, 0); PG8_LDB(B1, 1, 1); PG8_SCHED; PG8_LDA(At, 1, 0); PG8_STAGE(PG8_SA(0, 1), a2 + hstep, voffA);
            PG8_WAIT_V(8); PG8_WAIT_L(0); PG8_BAR; PG8_MMA(0, 0, At, B0); PG8_MMA(0, 1, At, B1); PG8_BAR; PG8_SCHED;
            PG8_LDA(At, 1, 1); PG8_STAGE(PG8_SB(1, 0), b3, voffB); PG8_STAGE(PG8_SB(1, 1), b3 + hstep, voffB); PG8_STAGE(PG8_SA(1, 0), a3, voffA);
            PG8_WAIT_V(8); PG8_WAIT_L(0); PG8_BAR; PG8_MMA(1, 0, At, B0); PG8_MMA(1, 1, At, B1); PG8_BAR; PG8_SCHED;
            } else {
            PG8_LDB(B0, 0, 0); PG8_SCHED; PG8_LDA(At, 0, 0); PG8_STAGE(PG8_SA(1, 1), a1 + hstep, voffA);
            PG8_WAIT_L(8); PG8_BAR; PG8_WAIT_L(0); PG8_MMA(0, 0, At, B0); PG8_BAR; PG8_SCHED;
            PG8_LDB(B1, 0, 1); PG8_STAGE(PG8_SB(0, 0), b2, voffB);
            PG8_BAR; PG8_WAIT_L(0); PG8_MMA(0, 1, At, B1); PG8_BAR;
            PG8_LDA(At, 0, 1); PG8_STAGE(PG8_SA(0, 0), a2, voffA);
            PG8_BAR; PG8_WAIT_L(0); PG8_MMA(1, 0, At, B0); PG8_BAR; PG8_SCHED;
            PG8_STAGE(PG8_SB(0, 1), b2 + hstep, voffB);
            PG8_WAIT_V(6); PG8_BAR; PG8_MMA(1, 1, At, B1); PG8_BAR;
            PG8_LDB(B0, 1, 0); PG8_SCHED; PG8_LDA(At, 1, 0); PG8_STAGE(PG8_SA(0, 1), a2 + hstep, voffA);
            PG8_WAIT_L(8); PG8_BAR; PG8_WAIT_L(0); PG8_MMA(0, 0, At, B0); PG8_BAR; PG8_SCHED;
            PG8_LDB(B1, 1, 1); PG8_STAGE(PG8_SB(1, 0), b3, voffB);
            PG8_BAR; PG8_WAIT_L(0); PG8_MMA(0, 1, At, B1); PG8_BAR;
            PG8_LDA(At, 1, 1); PG8_STAGE(PG8_SA(1, 0), a3, voffA);
            PG8_BAR; PG8_WAIT_L(0); PG8_MMA(1, 0, At, B0); PG8_BAR; PG8_SCHED;
            PG8_STAGE(PG8_SB(1, 1), b3 + hstep, voffB);
            PG8_WAIT_V(6); PG8_BAR; PG8_MMA(1, 1, At, B1); PG8_BAR;
            }
        }
        if constexpr (ALIGN_EPI) { if (wr == 0) PG8_BAR; }
        if constexpr (F8) asm volatile("s_nop 15\n\ts_nop 15" ::: "memory");
        if constexpr (!Epi::AFTER_DRAIN) { E(acc, cur, wr, wc, fr, fq); S.done(cur); }
        if (!has_next) break;
#pragma unroll
        for (int a = 0; a < 2; ++a)
#pragma unroll
            for (int b = 0; b < 2; ++b)
#pragma unroll
                for (int m = 0; m < 4; ++m)
#pragma unroll
                    for (int n = 0; n < 2; ++n) acc[a][b][m][n] = (f32x4){0.f, 0.f, 0.f, 0.f};
        cur = nxt; cA = nA; cB = nB; ++ui;
        if constexpr (ALIGN_EPI) { if (wr == 1) PG8_BAR; }
    }
    PG8_WAIT_V(0);
    if constexpr (!ALIGN_EPI) { if (wr == 0) PG8_BAR; }
    PG8_BAR;
    if constexpr (Epi::AFTER_DRAIN) { E.fused(acc, cur, wr, wc, fr, fq, lds, wid, lane); S.done(cur); }
#undef PG8_SA
#undef PG8_SB
#undef PG8_STAGE
#undef PG8_LDA
#undef PG8_LDB
#undef PG8_MMA
#undef PG8_WAIT_V
#undef PG8_WAIT_L
#undef PG8_BAR
#undef PG8_SCHED
}
}

#include <hip/hip_bf16.h>
#include <cmath>
namespace attn_body {
using bf16=__hip_bfloat16;
using bf16x8=__attribute__((ext_vector_type(8)))short;
using s16x4=__attribute__((ext_vector_type(4)))short;
using f32x16=__attribute__((ext_vector_type(16)))float;
using u32x4=__attribute__((ext_vector_type(4)))unsigned;
constexpr int D=64,QP=1536,KP=1536,OP=1024,NKEYS=16640;
constexpr int NW=8,QBLK=32,QB=QBLK*NW,KVBLK=64;
constexpr int ATTN_UNIT_ROWS=QB;
__device__ __forceinline__ int crow(int r,int hi){return (r&3)+8*(r>>2)+4*hi;}
#define SBAR() __builtin_amdgcn_sched_barrier(0)
__device__ __forceinline__ void cmask(f32x16&p0,f32x16&p1,int jb,int qrel,int hi){
  const float NEG=-INFINITY; int kb=64*jb+4*hi;
  #pragma unroll
  for(int r=0;r<16;++r){int kv=kb+(r&3)+8*(r>>2); if(kv>qrel)p0[r]=NEG; if(kv+32>qrel)p1[r]=NEG;}
}

constexpr int NSLOT=3, SLOTB=8192;
constexpr int LDS_K=0, LDS_V=NSLOT*SLOTB, LDS_WS=2*NSLOT*SLOTB, LDS_OST=LDS_WS+NW*64*4, LDS_BYTES=LDS_OST+NW*4096;
constexpr float C2=0.125f*1.4426950408889634f;
__device__ __forceinline__ void glds16(const void*gsrc,unsigned lds_dst){unsigned keep;
  asm volatile("s_mov_b32 %0, m0\n\ts_mov_b32 m0, %2\n\ts_nop 0\n\tglobal_load_lds_dwordx4 %1, off\n\ts_mov_b32 m0, %0":"=&s"(keep):"v"(gsrc),"s"(lds_dst):"memory");}
__device__ __forceinline__ float max3f(float a,float b,float c){float r;asm("v_max3_f32 %0, %1, %2, %3":"=v"(r):"v"(a),"v"(b),"v"(c));return r;}
__device__ __forceinline__ float max2f(float a,float b){float r;asm("v_max_f32_e32 %0, %1, %2":"=v"(r):"v"(a),"v"(b));return r;}
__device__ __forceinline__ float fadd_s(float a,float b){float r;asm("v_add_f32_e32 %0, %1, %2":"=v"(r):"v"(a),"v"(b));return r;}
__device__ __forceinline__ float fsub_s(float a,float b){float r;asm("v_sub_f32_e32 %0, %1, %2":"=v"(r):"v"(a),"v"(b));return r;}
typedef float f32x2_t __attribute__((ext_vector_type(2))); typedef __bf16 bf16x2_t __attribute__((ext_vector_type(2)));
__device__ __forceinline__ unsigned cvtpk_s(float lo,float hi){f32x2_t v={lo,hi};bf16x2_t b=__builtin_convertvector(v,bf16x2_t);return __builtin_bit_cast(unsigned,b);}
#define WAIT_BAR(N) asm volatile("s_waitcnt vmcnt(" #N ") lgkmcnt(0)\n\ts_barrier":::"memory")

__device__ __forceinline__ void qkt(f32x16&p0,f32x16&p1,const char*Kslot,const bf16x8*qr,const f32x16&negm,int r32,int hi){
  const char*kb=Kslot+hi*1024+r32*16;
  #pragma unroll
  for(int d0=0;d0<4;++d0){
    const bf16x8 b0=*reinterpret_cast<const bf16x8*>(kb+d0*2048);
    const bf16x8 b1=*reinterpret_cast<const bf16x8*>(kb+d0*2048+512);
    if(d0==0){p0=__builtin_amdgcn_mfma_f32_32x32x16_bf16(b0,qr[0],negm,0,0,0);p1=__builtin_amdgcn_mfma_f32_32x32x16_bf16(b1,qr[0],negm,0,0,0);}
    else{p0=__builtin_amdgcn_mfma_f32_32x32x16_bf16(b0,qr[d0],p0,0,0,0);p1=__builtin_amdgcn_mfma_f32_32x32x16_bf16(b1,qr[d0],p1,0,0,0);}}
}
typedef __attribute__((address_space(3))) const char* lds_cptr;
typedef short v4i16_t __attribute__((ext_vector_type(4)));
__device__ __forceinline__ void kload8(bf16x8*kf,lds_cptr kp){
  kf[0]=*(const __attribute__((address_space(3))) bf16x8*)(kp);      kf[1]=*(const __attribute__((address_space(3))) bf16x8*)(kp+512);
  kf[2]=*(const __attribute__((address_space(3))) bf16x8*)(kp+2048); kf[3]=*(const __attribute__((address_space(3))) bf16x8*)(kp+2560);
  kf[4]=*(const __attribute__((address_space(3))) bf16x8*)(kp+4096); kf[5]=*(const __attribute__((address_space(3))) bf16x8*)(kp+4608);
  kf[6]=*(const __attribute__((address_space(3))) bf16x8*)(kp+6144); kf[7]=*(const __attribute__((address_space(3))) bf16x8*)(kp+6656);
}
__device__ __forceinline__ void kload2(bf16x8*kf,lds_cptr kp,int j){ kf[2*j]=*(const __attribute__((address_space(3))) bf16x8*)(kp+j*2048); kf[2*j+1]=*(const __attribute__((address_space(3))) bf16x8*)(kp+j*2048+512); }
__device__ __forceinline__ s16x4 vtr(lds_cptr p){ return __builtin_bit_cast(s16x4,__builtin_amdgcn_ds_read_tr16_b64_v4i16((__attribute__((address_space(3))) v4i16_t*)p)); }
__device__ __forceinline__ float rowmax(const f32x16&p0,const f32x16&p1){
  float a=max3f(p0[0],p0[1],p1[0]),b=max3f(p0[2],p0[3],p1[1]);a=max3f(a,p1[2],p1[3]);
  #pragma unroll
  for(int r=4;r<16;r+=4){a=max3f(a,p0[r],p0[r+1]);b=max3f(b,p0[r+2],p0[r+3]);a=max3f(a,p1[r],p1[r+1]);b=max3f(b,p1[r+2],p1[r+3]);}
  const float m=max2f(a,b);
  auto rr=__builtin_amdgcn_permlane32_swap(__float_as_uint(m),__float_as_uint(m),false,false);
  return max2f(__uint_as_float(rr[0]),__uint_as_float(rr[1]));
}
__device__ __forceinline__ void pv(f32x16*o,int vb,bf16x8 pa0,bf16x8 pa1,bf16x8 pa2,bf16x8 pa3){
  #pragma unroll
  for(int d0=0;d0<2;++d0){s16x4 lo[4],hi[4];
    #pragma unroll
    for(int ks=0;ks<4;++ks){
      asm volatile("ds_read_b64_tr_b16 %0,%1 offset:%c2":"=&v"(lo[ks]):"v"(vb),"i"(d0*4096+ks*1024):"memory");
      asm volatile("ds_read_b64_tr_b16 %0,%1 offset:%c2":"=&v"(hi[ks]):"v"(vb),"i"(d0*4096+ks*1024+512):"memory");}
    asm volatile("s_waitcnt lgkmcnt(0)":::"memory");SBAR();
    #define PK(k) (bf16x8){lo[k][0],lo[k][1],lo[k][2],lo[k][3],hi[k][0],hi[k][1],hi[k][2],hi[k][3]}
    o[d0]=__builtin_amdgcn_mfma_f32_32x32x16_bf16(pa0,PK(0),o[d0],0,0,0);
    o[d0]=__builtin_amdgcn_mfma_f32_32x32x16_bf16(pa1,PK(1),o[d0],0,0,0);
    o[d0]=__builtin_amdgcn_mfma_f32_32x32x16_bf16(pa2,PK(2),o[d0],0,0,0);
    o[d0]=__builtin_amdgcn_mfma_f32_32x32x16_bf16(pa3,PK(3),o[d0],0,0,0);
    #undef PK
  }
}

#ifndef ATTN_STORE16
#define ATTN_STORE16(p,v) (*(u32x4*)(p)=(v))
#endif
template<int THRL> __device__ __forceinline__ void attn_unit(int hq,int kvh,int qb,const bf16*Q,const bf16*__restrict__ K,const bf16*__restrict__ V,bf16*O,char*shm){
  const int tid=threadIdx.x,lane=tid&63,r32=lane&31,hi=lane>>5; const int wid=__builtin_amdgcn_readfirstlane(tid>>6);
  const int q0=qb*QB;
  const bf16*Qw=Q+(long)(q0+wid*QBLK)*QP+hq*D;
  const bf16*Kh=K+kvh*D,*Vh=V+kvh*D;
  const unsigned lds0=(unsigned)(uintptr_t)shm;
  float*wsf=(float*)(shm+LDS_WS)+wid*64;
  const bf16*ksrc=Kh+(long)lane*KP+wid*8;
  const bf16*vsrc=Vh+(long)(16*(wid&3)+(lane>>2))*KP+(wid>>2)*32+(lane&3)*8;
  const unsigned kdst=lds0+LDS_K+wid*1024, vdst=lds0+LDS_V+wid*1024;
  #define DMA_K(t,slot) glds16(ksrc+(long)(t)*KVBLK*KP,(unsigned)__builtin_amdgcn_readfirstlane(kdst+(slot)))
  #define DMA_V(t,slot) glds16(vsrc+(long)(t)*KVBLK*KP,(unsigned)__builtin_amdgcn_readfirstlane(vdst+(slot)))
  const int vb0=(int)(lds0+LDS_V)+((lane>>4)&1)*32+(lane&3)*8+(4*hi+((lane&15)>>2))*64;
  const char*Kbase=shm+LDS_K; bf16x8 kf[8];
  const lds_cptr shm3=(lds_cptr)shm; const lds_cptr kp0=shm3+LDS_K+hi*1024+r32*16; const lds_cptr vp0=shm3+LDS_V+((lane>>4)&1)*32+(lane&3)*8+(4*hi+((lane&15)>>2))*64;
  const int NT=NKEYS/KVBLK;
  DMA_K(0,0);DMA_V(0,0);DMA_K(1,SLOTB);
  bf16x8 qr[4];
  #pragma unroll
  for(int d0=0;d0<4;++d0)qr[d0]=*reinterpret_cast<const bf16x8*>(&Qw[(long)r32*QP+d0*16+hi*8]);
  float mhat=0.f,l_reg=0.f;f32x16 o[2];o[0]=f32x16{};o[1]=f32x16{};f32x16 negm=f32x16{};asm volatile("":"+v"(negm));
    #define CMASK(P0,P1,t) do{}while(0)
  bool resc=false;
  #define START(P0,P1) do{ const float rm=rowmax(P0,P1); resc=false; \
    { const float dl=rm; mhat=fadd_s(mhat,dl); \
      _Pragma("unroll") for(int r=0;r<16;++r){P0[r]=fsub_s(P0[r],dl);P1[r]=fsub_s(P1[r],dl);} \
      _Pragma("unroll") for(int r=0;r<16;++r)negm[r]=-mhat; asm volatile("":"+v"(negm)); } \
    _Pragma("unroll") for(int r=0;r<16;++r)P0[r]=__builtin_amdgcn_exp2f(P0[r]); }while(0)
  #define RESC() do{ if(resc){ asm volatile("s_waitcnt lgkmcnt(0)":::"memory"); \
      _Pragma("unroll") for(int d_=0;d_<2;++d_) _Pragma("unroll") for(int r=0;r<16;++r)o[d_][r]*=wsf[crow(r,hi)]; } }while(0)
  f32x16 pA0,pA1,pB0,pB1;
  int sl_prev=0,sl_cur=0,sl_next=SLOTB;
  #define ROT() do{sl_prev=sl_cur;sl_cur=sl_next;sl_next=(sl_next==(NSLOT-1)*SLOTB)?0:sl_next+SLOTB;}while(0)
  DMA_K(2,2*SLOTB);
  WAIT_BAR(3);
  qkt(pA0,pA1,Kbase,qr,negm,r32,hi);asm volatile("s_nop 15\n\ts_nop 7":"+v"(pA0),"+v"(pA1));CMASK(pA0,pA1,0);
  START(pA0,pA1);
  _Pragma("unroll") for(int r=0;r<16;++r)pA1[r]=__builtin_amdgcn_exp2f(pA1[r]);
  WAIT_BAR(0);
  DMA_K(3,0);DMA_V(1,SLOTB);
  ROT();
  kload8(kf,kp0+sl_cur);
  WAIT_BAR(2);
  s16x4 vlo[8],vhi[8]; u32x4 pw0,pw1,pw2,pw3;
  #define PKW(P,B) cvtpk_s(P[B],P[B+1])
  #define PAF(k) __builtin_bit_cast(bf16x8,pw##k)
  #define VFR(i) (bf16x8){vlo[i][0],vlo[i][1],vlo[i][2],vlo[i][3],vhi[i][0],vhi[i][1],vhi[i][2],vhi[i][3]}
  #define PIN(x) asm volatile("":"+v"(x))
  #define MX3(a,b,c) __builtin_fmaxf(__builtin_fmaxf((a),(b)),(c))
  #define GAPA(MF,A0,A1,A2,A3,W0,W1,PW) do{ MF; sacc+=A0; sacc+=A1; sacc+=A2; sacc+=A3; PIN(sacc); W0; W1; PIN(PW); SBAR(); }while(0)
  #define EX(v) __builtin_amdgcn_exp2f(v)
  #define GAPB(MF,X,B) do{ MF; X[B]=EX(X[B]); X[B+1]=EX(X[B+1]); X[B+2]=EX(X[B+2]); X[B+3]=EX(X[B+3]); PIN(X); SBAR(); }while(0)
  #define VRD(i) do{ vlo[i]=vtr(vp_+(((i)>>2)*4096+((i)&3)*1024)); vhi[i]=vtr(vp_+(((i)>>2)*4096+((i)&3)*1024+512)); }while(0)
  #define KRD(G,j) do{ if(G){ kload2(kf,kp0+sl_next,j); SBAR(); } }while(0)
  #define STEP(C0,C1,P0,P1,t,GK,GV,GL) do{ SBAR(); \
    const lds_cptr vp_=vp0+sl_prev; \
    VRD(0); SBAR(); float sacc=(P0[0]+P0[1]); \
    GAPA(C0=__builtin_amdgcn_mfma_f32_32x32x16_bf16(kf[0],qr[0],negm,0,0,0), P0[2],P0[3],P0[4],P0[5],     pw0[0]=PKW(P0,0), pw0[1]=PKW(P0,2), pw0); \
    VRD(4); SBAR(); GAPA(C1=__builtin_amdgcn_mfma_f32_32x32x16_bf16(kf[1],qr[0],negm,0,0,0), P0[6],P0[7],P0[8],P0[9],     pw0[2]=PKW(P0,4), pw0[3]=PKW(P0,6), pw0); \
    VRD(1); SBAR(); GAPA(C0=__builtin_amdgcn_mfma_f32_32x32x16_bf16(kf[2],qr[1],C0,0,0,0),   P0[10],P0[11],P0[12],P0[13], pw1[0]=PKW(P0,8), pw1[1]=PKW(P0,10), pw1); \
    VRD(5); SBAR(); GAPA(C1=__builtin_amdgcn_mfma_f32_32x32x16_bf16(kf[3],qr[1],C1,0,0,0),   P0[14],P0[15],P1[0],P1[1],   pw1[2]=PKW(P0,12),pw1[3]=PKW(P0,14), pw1); \
    VRD(2); SBAR(); GAPA(C0=__builtin_amdgcn_mfma_f32_32x32x16_bf16(kf[4],qr[2],C0,0,0,0),   P1[2],P1[3],P1[4],P1[5],     pw2[0]=PKW(P1,0), pw2[1]=PKW(P1,2), pw2); \
    VRD(6); SBAR(); GAPA(C1=__builtin_amdgcn_mfma_f32_32x32x16_bf16(kf[5],qr[2],C1,0,0,0),   P1[6],P1[7],P1[8],P1[9],     pw2[2]=PKW(P1,4), pw2[3]=PKW(P1,6), pw2); \
    VRD(3); SBAR(); GAPA(C0=__builtin_amdgcn_mfma_f32_32x32x16_bf16(kf[6],qr[3],C0,0,0,0),   P1[10],P1[11],P1[12],P1[13], pw3[0]=PKW(P1,8), pw3[1]=PKW(P1,10), pw3); \
    VRD(7); SBAR(); GAPA(C1=__builtin_amdgcn_mfma_f32_32x32x16_bf16(kf[7],qr[3],C1,0,0,0),   P1[14],P1[15],0.f,0.f,       pw3[2]=PKW(P1,12),pw3[3]=PKW(P1,14), pw3); \
    l_reg+=sacc; \
    if(GK){DMA_K((t)+3,sl_cur);} if(GV){DMA_V((t)+1,sl_next);} \
    CMASK(C0,C1,t); \
    { float a=MX3(C0[0],C0[1],C1[0]),b=MX3(C0[2],C0[3],C1[1]); a=MX3(a,C1[2],C1[3]); \
      _Pragma("unroll") for(int r=4;r<16;r+=4){a=MX3(a,C0[r],C0[r+1]);b=MX3(b,C0[r+2],C0[r+3]);a=MX3(a,C1[r],C1[r+1]);b=MX3(b,C1[r+2],C1[r+3]);} \
      float rm=__builtin_fmaxf(a,b); { auto rr=__builtin_amdgcn_permlane32_swap(__float_as_uint(rm),__float_as_uint(rm),false,false); rm=__builtin_fmaxf(__uint_as_float(rr[0]),__uint_as_float(rr[1])); } \
      resc=false; \
      if(__builtin_expect(__any(rm>(float)THRL),0)){ const float dl=__builtin_fmaxf(rm,0.f); mhat+=dl; \
        _Pragma("unroll") for(int r=0;r<16;++r){C0[r]-=dl;C1[r]-=dl;} \
        _Pragma("unroll") for(int r=0;r<16;++r)negm[r]=-mhat; asm volatile("":"+v"(negm)); \
        const float f=__builtin_amdgcn_exp2f(-dl); l_reg*=f; if(hi==0)wsf[r32]=f; resc=true; } } \
    SBAR(); \
    GAPB(o[0]=__builtin_amdgcn_mfma_f32_32x32x16_bf16(PAF(0),VFR(0),o[0],0,0,0), C0,0); \
    GAPB(o[1]=__builtin_amdgcn_mfma_f32_32x32x16_bf16(PAF(0),VFR(4),o[1],0,0,0), C0,4); \
    KRD(GL,0); GAPB(o[0]=__builtin_amdgcn_mfma_f32_32x32x16_bf16(PAF(1),VFR(1),o[0],0,0,0), C0,8); \
    KRD(GL,1); GAPB(o[1]=__builtin_amdgcn_mfma_f32_32x32x16_bf16(PAF(1),VFR(5),o[1],0,0,0), C0,12); \
    KRD(GL,2); GAPB(o[0]=__builtin_amdgcn_mfma_f32_32x32x16_bf16(PAF(2),VFR(2),o[0],0,0,0), C1,0); \
    KRD(GL,3); GAPB(o[1]=__builtin_amdgcn_mfma_f32_32x32x16_bf16(PAF(2),VFR(6),o[1],0,0,0), C1,4); \
    GAPB(o[0]=__builtin_amdgcn_mfma_f32_32x32x16_bf16(PAF(3),VFR(3),o[0],0,0,0), C1,8); \
    GAPB(o[1]=__builtin_amdgcn_mfma_f32_32x32x16_bf16(PAF(3),VFR(7),o[1],0,0,0), C1,12); \
    }while(0)
  int t=1;
  #undef CMASK
  #define CMASK(P0,P1,t) do{}while(0)
  for(;t+5<NT;t+=2){
    STEP(pB0,pB1,pA0,pA1,t,true,true,true);     WAIT_BAR(2); RESC(); ROT();
    STEP(pA0,pA1,pB0,pB1,t+1,true,true,true);   WAIT_BAR(2); RESC(); ROT();
  }
  #undef CMASK
  #define CMASK(P0,P1,t) do{}while(0)
  #define ENDW(tt) do{ if((tt)+3<NT){WAIT_BAR(2);} else if((tt)+2<NT){WAIT_BAR(1);} else {WAIT_BAR(0);} }while(0)
  for(;t+1<NT;t+=2){
    STEP(pB0,pB1,pA0,pA1,t,(t+3<NT),(t+1<NT),(t+1<NT));       ENDW(t);   RESC(); ROT();
    STEP(pA0,pA1,pB0,pB1,t+1,(t+4<NT),(t+2<NT),(t+2<NT));     ENDW(t+1); RESC(); ROT();
  }
  STEP(pB0,pB1,pA0,pA1,NT-1,false,false,false); RESC();
  { float sacc=pB0[0]+pB0[1]; _Pragma("unroll") for(int r=2;r<16;++r)sacc+=pB0[r]; _Pragma("unroll") for(int r=0;r<16;++r)sacc+=pB1[r]; l_reg+=sacc;
    pw0=(u32x4){PKW(pB0,0),PKW(pB0,2),PKW(pB0,4),PKW(pB0,6)};pw1=(u32x4){PKW(pB0,8),PKW(pB0,10),PKW(pB0,12),PKW(pB0,14)};pw2=(u32x4){PKW(pB1,0),PKW(pB1,2),PKW(pB1,4),PKW(pB1,6)};pw3=(u32x4){PKW(pB1,8),PKW(pB1,10),PKW(pB1,12),PKW(pB1,14)};
    SBAR(); pv(o,vb0+sl_cur,PAF(0),PAF(1),PAF(2),PAF(3)); }
  #undef PKW
  #undef PAF
  #undef VFR
  #undef PIN
  #undef MX3
  #undef GAPA
  #undef GAPB
  #undef EX
  #undef VRD
  #undef KRD
  #undef STEP
  #undef ENDW
  {auto rr=__builtin_amdgcn_permlane32_swap(__float_as_uint(l_reg),__float_as_uint(l_reg),false,false);l_reg=__uint_as_float(rr[0])+__uint_as_float(rr[1]);}
  if(hi==0)wsf[32+r32]=l_reg;asm volatile("s_waitcnt lgkmcnt(0)":::"memory");
  float rli[16];
  #pragma unroll
  for(int r=0;r<16;++r)rli[r]=__builtin_amdgcn_rcpf(wsf[32+crow(r,hi)]);
  bf16*Ow=O+(long)(q0+wid*QBLK)*OP+hq*D;
  { bf16*stg=(bf16*)(shm+LDS_OST)+wid*2048;
    #pragma unroll
    for(int r=0;r<16;++r){const int orow=crow(r,hi);
      #pragma unroll
      for(int d0=0;d0<2;++d0)stg[orow*64+d0*32+r32]=__float2bfloat16(o[d0][r]*rli[r]);}
    asm volatile("s_waitcnt lgkmcnt(0)":::"memory");
    #pragma unroll
    for(int i=0;i<4;++i){const int row=i*8+(lane>>3),ch=lane&7; const u32x4 v=*(const u32x4*)(stg+row*64+ch*8); ATTN_STORE16(Ow+(long)row*OP+ch*8,v);} }
  asm volatile("s_waitcnt lgkmcnt(0)\n\ts_barrier":::"memory");
  #undef DMA_K
  #undef DMA_V
  #undef CMASK
  #undef START
  #undef RESC
  #undef ROT
}
constexpr int ATTN_LDS_BYTES=LDS_BYTES;
struct AttnTensors { const bf16* Q; const bf16* K; const bf16* V; bf16* O; };
struct AttnUnit { int hq; int kvh; int qb; };
struct GqaOrder {
  int vcu;
  __device__ __forceinline__ explicit GqaOrder(int grid,int block):vcu((block%8)*(grid/8)+block/8){}
  __device__ __forceinline__ bool next(int i,AttnUnit&u)const{ if(i>=3)return false; const int x=vcu>>5; u.kvh=x>>1; u.hq=u.kvh*3+i; u.qb=(x&1)*32+(vcu&31); return true; }
};
template<class Sched,int THRL=8> __device__ __forceinline__ void attn_phase(char*lds,const AttnTensors&T,const Sched&S){
  AttnUnit u;
  for(int i=0;S.next(i,u);++i){ attn_unit<THRL>(u.hq,u.kvh,u.qb,T.Q,T.K,T.V,T.O,lds); }
}
#undef SBAR
#undef WAIT_BAR
}

namespace attn8 {
using bf16 = __hip_bfloat16;
using f32x16 = __attribute__((ext_vector_type(16))) float;
using v8i = __attribute__((ext_vector_type(8))) int;
using v4i = __attribute__((ext_vector_type(4))) int;
using u32x4 = __attribute__((ext_vector_type(4))) unsigned;
constexpr int NKEYS = 16640, NT = NKEYS / 64, NQ = 16384, OP = 1024;
constexpr int SLOT = 4096, NSLOT = 8;
constexpr int LDS_K = 0, LDS_V = NSLOT * SLOT, LDS_WS = 2 * NSLOT * SLOT, LDS_OST = LDS_WS + 8 * 64 * 4, LDS_BYTES = LDS_OST + 8 * 4096;
typedef __attribute__((address_space(3))) const char* lds_cptr;
__device__ __forceinline__ int crow(int r, int hi) { return (r & 3) + 8 * (r >> 2) + 4 * hi; }
__device__ __forceinline__ void glds16(const void* gsrc, unsigned lds_dst) { unsigned keep;
    asm volatile("s_mov_b32 %0, m0\n\ts_mov_b32 m0, %2\n\ts_nop 0\n\tglobal_load_lds_dwordx4 %1, off\n\ts_mov_b32 m0, %0" : "=&s"(keep) : "v"(gsrc), "s"(lds_dst) : "memory"); }
__device__ __forceinline__ v8i ldfrag(lds_cptr tile, int row, int hi) {
    const int sw = (row >> 2) & 3; lds_cptr p = tile + row * 64;
    const v4i a = *(const __attribute__((address_space(3))) v4i*)(p + (((2 * hi) ^ sw) << 4)), b = *(const __attribute__((address_space(3))) v4i*)(p + (((2 * hi + 1) ^ sw) << 4));
    return __builtin_shufflevector(a, b, 0, 1, 2, 3, 4, 5, 6, 7); }
__device__ __forceinline__ f32x16 mfma8(v8i a, v8i b, f32x16 c) { return __builtin_amdgcn_mfma_scale_f32_32x32x64_f8f6f4(a, b, c, 0, 0, 0, 0, 0, 0); }
__device__ __forceinline__ unsigned short f2bf16(float f) { const unsigned u = __builtin_bit_cast(unsigned, f); return (unsigned short)((u + 0x7fffu + ((u >> 16) & 1u)) >> 16); }
__device__ __forceinline__ float max3f(float a, float b, float c) { return __builtin_fmaxf(__builtin_fmaxf(a, b), c); }

template <int THRL>
__device__ __forceinline__ void attn_unit(int hq, int kvh, int qb, const unsigned char* Q8, const unsigned char* K8, const unsigned char* VT8, const float* qnorm, const unsigned* kmaxw, bf16* O, char* shm) {
    const int tid = threadIdx.x, lane = tid & 63, r32 = lane & 31, hi = lane >> 5; const int wid = __builtin_amdgcn_readfirstlane(tid >> 6);
    const unsigned lds0 = (unsigned)(uintptr_t)shm;
    const lds_cptr shm3 = (lds_cptr)shm;
    __attribute__((address_space(3))) float* wsf = (__attribute__((address_space(3))) float*)(shm3 + LDS_WS) + wid * 64;
    const unsigned char* ksrc = K8 + (size_t)kvh * NT * SLOT + wid * 512 + r32 * 16;
    const unsigned char* vsrc = VT8 + (size_t)kvh * NT * SLOT + wid * 512 + r32 * 16;
    const unsigned kdst = lds0 + LDS_K + wid * 512, vdst = lds0 + LDS_V + wid * 512;
#define A8_DMAK(t, slot) do { if (lane < 32) glds16(ksrc + (size_t)(t) * SLOT, (unsigned)__builtin_amdgcn_readfirstlane(kdst + (slot) * SLOT)); } while (0)
#define A8_DMAV(t, slot) do { if (lane < 32) glds16(vsrc + (size_t)(t) * SLOT, (unsigned)__builtin_amdgcn_readfirstlane(vdst + (slot) * SLOT)); } while (0)
    v8i qf; { const unsigned char* qp = Q8 + ((size_t)hq * NQ + qb * 256 + wid * 32 + r32) * 64 + hi * 32; const v4i a = *(const v4i*)qp, b = *(const v4i*)(qp + 16); qf = __builtin_shufflevector(a, b, 0, 1, 2, 3, 4, 5, 6, 7); }
    asm volatile("s_waitcnt vmcnt(0)" : "+v"(qf) : : "memory");
    constexpr int LEAD = NSLOT - 2;
    const bool grpB = wid >= 4;
    A8_DMAK(0, 0);
#pragma unroll
    for (int jj = 0; jj < LEAD; ++jj) { A8_DMAK(jj + 1, jj + 1); A8_DMAV(jj, jj); }
    f32x16 o0 = {}, o1 = {}, o2 = {}, negm;
    { const float qn = qnorm[(size_t)hq * NQ + qb * 256 + wid * 32 + r32], km = __uint_as_float(*kmaxw); const float nref = 8.7f - qn * km * 1.0001f;
#pragma unroll
      for (int r = 0; r < 16; ++r) negm[r] = nref; }
    asm volatile("s_waitcnt vmcnt(0)" : "+v"(negm) : : "memory");
    const int ob = 0x38383838; const v8i ones = {ob, ob, ob, ob, ob, ob, ob, ob};
    asm volatile("s_waitcnt vmcnt(%0) lgkmcnt(0)\n\ts_barrier" :: "n"(2 * (LEAD - 1)) : "memory");
    f32x16 s0, s1;
    { const lds_cptr kt = shm3 + LDS_K; const v8i k0 = ldfrag(kt, r32, hi), k1 = ldfrag(kt, 32 + r32, hi); s0 = mfma8(k0, qf, negm); s1 = mfma8(k1, qf, negm); }
    if (grpB) asm volatile("s_barrier" ::: "memory");
    int s_cur = 0;
#pragma unroll 1
    for (int t = 0; t < NT; ++t) {
#pragma unroll
        for (int r = 0; r < 16; ++r) { s0[r] = __builtin_amdgcn_exp2f(s0[r]); s1[r] = __builtin_amdgcn_exp2f(s1[r]); }
        v8i pa;
#pragma unroll
        for (int j = 0; j < 4; ++j) { int w, x;
            asm("v_cvt_pk_fp8_f32 %0, %1, %2" : "=v"(w) : "v"(s0[4 * j]), "v"(s0[4 * j + 1])); w = __builtin_amdgcn_cvt_pk_fp8_f32(s0[4 * j + 2], s0[4 * j + 3], w, true); pa[j] = w;
            asm("v_cvt_pk_fp8_f32 %0, %1, %2" : "=v"(x) : "v"(s1[4 * j]), "v"(s1[4 * j + 1])); x = __builtin_amdgcn_cvt_pk_fp8_f32(s1[4 * j + 2], s1[4 * j + 3], x, true); pa[4 + j] = x; }
        asm volatile("s_waitcnt lgkmcnt(0)\n\ts_barrier" : "+v"(pa) : : "memory");
        const int s_nx = (s_cur + 1 == NSLOT) ? 0 : s_cur + 1;
        { const int pj = t + LEAD, tk = (pj + 1 < NT) ? pj + 1 : NT - 1, tv = (pj < NT) ? pj : NT - 1;
          int sk = s_nx + LEAD; sk = sk >= NSLOT ? sk - NSLOT : sk; int sv = s_cur + LEAD; sv = sv >= NSLOT ? sv - NSLOT : sv; A8_DMAK(tk, sk); A8_DMAV(tv, sv); }
        const lds_cptr kt = shm3 + LDS_K + s_nx * SLOT, vt = shm3 + LDS_V + s_cur * SLOT;
        const v8i v0 = ldfrag(vt, r32, hi), v1 = ldfrag(vt, 32 + r32, hi);
        const v8i k0 = ldfrag(kt, r32, hi), k1 = ldfrag(kt, 32 + r32, hi);
        o0 = mfma8(pa, v0, o0); o1 = mfma8(pa, v1, o1); o2 = mfma8(pa, ones, o2);
        if (t + 1 < NT) { s0 = mfma8(k0, qf, negm); s1 = mfma8(k1, qf, negm); }
        asm volatile("s_waitcnt vmcnt(%0) lgkmcnt(0)\n\ts_barrier" :: "n"(2 * (LEAD - 1)) : "memory");
        s_cur = s_nx;
    }
    if (!grpB) asm volatile("s_barrier" ::: "memory");
    asm volatile("s_waitcnt vmcnt(0) lgkmcnt(0)\n\ts_barrier" ::: "memory");
    float rli[16];
#pragma unroll
    for (int r = 0; r < 16; ++r) rli[r] = __builtin_amdgcn_rcpf(o2[r]);
    bf16* Ow = O + (long)(qb * 256 + wid * 32) * OP + hq * 64;
    { __attribute__((address_space(3))) unsigned short* stg = (__attribute__((address_space(3))) unsigned short*)(shm3 + LDS_OST) + wid * 2048;
#pragma unroll
      for (int r = 0; r < 16; ++r) { const int orow = crow(r, hi); stg[orow * 64 + r32] = f2bf16(o0[r] * rli[r]); stg[orow * 64 + 32 + r32] = f2bf16(o1[r] * rli[r]); }
      asm volatile("s_waitcnt lgkmcnt(0)" ::: "memory");
#pragma unroll
      for (int i = 0; i < 4; ++i) { const int row = i * 8 + (lane >> 3), ch = lane & 7; const u32x4 v = *(const __attribute__((address_space(3))) u32x4*)(stg + row * 64 + ch * 8); *(u32x4*)(Ow + (long)row * OP + ch * 8) = v; } }
    asm volatile("s_waitcnt vmcnt(0) lgkmcnt(0)\n\ts_barrier" ::: "memory");
#undef A8_DMAK
#undef A8_DMAV
}
struct Tensors { const unsigned char* Q8; const unsigned char* K8; const unsigned char* VT8; const float* qnorm; const unsigned* kmax; bf16* O; };
template <int THRL = 8> __device__ __forceinline__ void attn_phase(char* lds, const Tensors& T, int grid, int block) {
    const int vcu = (block % 8) * (grid / 8) + block / 8, x = vcu >> 5, kvh = x >> 1, qb = (x & 1) * 32 + (vcu & 31);
#pragma unroll 1
    for (int i = 0; i < 3; ++i) attn_unit<THRL>(kvh * 3 + i, kvh, qb, T.Q8, T.K8, T.VT8, T.qnorm, T.kmax + 64 * kvh, T.O, lds);
}
}


constexpr int NWAVES = 8;
#ifndef MK_N_LAUNCHES
#define MK_N_LAUNCHES 1
#endif
constexpr int NPH = 18;

constexpr int SEQ = 16384, DMODEL = 1024, CTXL = 256, MROWS = SEQ + CTXL;
constexpr int NQKVF = 1536, KCOL = 768, VCOL = 1024, FCOL = 1280;
constexpr int DFF = 2816, DEXP = 3584, NEXP = 8;
constexpr int MOE_TILES_MAX = 136;
constexpr float NEPS = 1e-6f;

constexpr size_t MiB = 1u << 20;
constexpr size_t WS_CTL = 0, CTL_ZERO_BYTES = 1 * MiB;
constexpr size_t WS_SMALL = 1 * MiB;
constexpr size_t SM_MOD0 = 0, SM_MOD1 = 32768, SM_CMOD = 65536, SM_BLKCNT = 81920, SM_TILEE = 98304, SM_TOKE = 131072, SM_TOKW = 262144, SM_TOKR = 393216, SM_TOKP = 524288;
constexpr size_t WS_WEGU = 2 * MiB, WS_WEDN = 58 * MiB, WS_WIN0 = 86 * MiB, WS_WOUT0 = 89 * MiB, WS_WGU0 = 91 * MiB, WS_WDN0 = 102 * MiB, WS_WIN1 = 108 * MiB, WS_WOUT1 = 114 * MiB;
constexpr size_t WS_H = 116 * MiB, WS_QKVF = 149 * MiB, WS_PB = 198 * MiB, WS_QB = 206 * MiB, WS_MIX = 214 * MiB, WS_Y = 246 * MiB;
constexpr size_t WS_ACT0 = 149 * MiB, WS_BCU = 149 * MiB, WS_VB = 278 * MiB;
constexpr size_t WS_H2 = 310 * MiB, WS_HPERM = 326 * MiB, WS_YP = 360 * MiB, WS_ACT1 = 149 * MiB, WS_END = 428 * MiB;
static_assert(WS_WEGU + (size_t)NEXP * DMODEL * 2 * DEXP <= WS_WEDN && WS_WEDN + (size_t)NEXP * DMODEL * DEXP <= WS_WIN0 && WS_WOUT1 + 2 * MiB <= WS_H, "weights");
static_assert(WS_H + (size_t)MROWS * DMODEL * 2 <= WS_QKVF && WS_QKVF + (size_t)MROWS * NQKVF * 2 <= WS_PB && WS_MIX + (size_t)SEQ * DMODEL * 2 <= WS_Y, "layer-0 mixer map");
static_assert(WS_ACT0 + (size_t)SEQ * DFF * 2 <= WS_Y && WS_BCU + (size_t)SEQ * 3 * DMODEL * 2 <= WS_Y && WS_Y + (size_t)SEQ * DMODEL * 2 <= WS_VB && WS_VB + (size_t)SEQ * DMODEL * 2 <= WS_H2, "ffn / conv map");
static_assert(WS_H2 + (size_t)SEQ * DMODEL <= WS_HPERM && WS_HPERM + (size_t)MOE_TILES_MAX * 256 * DMODEL <= WS_YP && WS_YP + (size_t)MOE_TILES_MAX * 256 * DMODEL * 2 <= WS_END && WS_ACT1 + (size_t)MOE_TILES_MAX * 256 * DEXP <= WS_H2, "moe map");
constexpr size_t WS_Q8 = 330 * MiB, WS_K8 = 344 * MiB, WS_VT8 = 350 * MiB, WS_QN = 356 * MiB, WS_MIX2 = 278 * MiB;
constexpr int CW_KMAX = 8128;
static_assert(WS_Q8 + (size_t)12 * SEQ * 64 <= WS_K8 && WS_K8 + (size_t)4 * MROWS * 64 <= WS_VT8 && WS_VT8 + (size_t)4 * MROWS * 64 <= WS_QN && WS_QN + (size_t)12 * SEQ * 4 <= WS_YP, "attention operand map");
constexpr float WSCALE_GU = 64.f, WSCALE_DN = 128.f;
constexpr int CW_BAR = 4096;

constexpr int RING_OFF = 0, RING_BYTES = 131072;
constexpr int LDSCTL_OFF = RING_BYTES;
constexpr int LDS_BYTES = 147456;

#define GAS __attribute__((address_space(1)))
#define LAS __attribute__((address_space(3)))
typedef unsigned short bf16;
typedef unsigned v4u __attribute__((ext_vector_type(4)));
typedef unsigned v2u __attribute__((ext_vector_type(2)));
typedef float f32x4 __attribute__((ext_vector_type(4)));
typedef short bf16x8 __attribute__((ext_vector_type(8)));
typedef GAS unsigned gu32;
__device__ __forceinline__ unsigned f2bf(float f) { unsigned u = __builtin_bit_cast(unsigned, f); return (u + 0x7fffu + ((u >> 16) & 1u)) >> 16; }
__device__ __forceinline__ unsigned pk2(float lo, float hi) { return f2bf(lo) | (f2bf(hi) << 16); }
__device__ __forceinline__ float bflo(unsigned w) { return __builtin_bit_cast(float, w << 16); }
__device__ __forceinline__ float bfhi(unsigned w) { return __builtin_bit_cast(float, w & 0xffff0000u); }
__device__ __forceinline__ float fast_exp(float x) { return __builtin_amdgcn_exp2f(x * 1.4426950408889634f); }
__device__ __forceinline__ float silu_f(float x) { return x * __builtin_amdgcn_rcpf(1.0f + fast_exp(-x)); }
__device__ __forceinline__ float wave_sum(float v) {
#pragma unroll
    for (int o = 1; o < 64; o <<= 1) v += __shfl_xor(v, o);
    return v;
}
__device__ __forceinline__ float sum4(f32x4 v) { return (v.x + v.y) + (v.z + v.w); }
__device__ __forceinline__ f32x4 ld_bf4(const bf16* p) { const v2u w = *(const v2u*)p; return (f32x4){bflo(w.x), bfhi(w.x), bflo(w.y), bfhi(w.y)}; }
__device__ __forceinline__ void st_bf4(bf16* p, f32x4 v) { v2u w; w.x = pk2(v.x, v.y); w.y = pk2(v.z, v.w); *(v2u*)p = w; }

#define XB_TMO      128
#define XB_XCNT(j)  (256  + 64 * (j))
#define XB_XSUB(j)  (1280 + 64 * (j))
#define XB_XGEN(j)  (2304 + 64 * (j))
#define XB_TOP      3328
#define XB_TOPGEN   3392
#define XCD_BAR_WORDS 3456
#define XB_SPIN_CAP (1u << 18)

__device__ __forceinline__ unsigned xb_ld(unsigned* p)              { return __hip_atomic_load(p, __ATOMIC_RELAXED, __HIP_MEMORY_SCOPE_AGENT); }
__device__ __forceinline__ unsigned xb_add(unsigned* p, unsigned v) { return __hip_atomic_fetch_add(p, v, __ATOMIC_RELAXED, __HIP_MEMORY_SCOPE_AGENT); }
__device__ __forceinline__ unsigned xb_xcc_id() { return (unsigned)__builtin_amdgcn_s_getreg((3 << 11) | 20) & 0xFu; }
#define XB_SPIN(cond, bar) do { unsigned _sp = 0; while (cond) { __builtin_amdgcn_s_sleep(1); \
    if ((++_sp & 255u) == 0u) { if (xb_ld(&(bar)[XB_TMO])) break; if (_sp > XB_SPIN_CAP) { atomicAdd(&(bar)[XB_TMO], 1u); break; } } } } while (0)

struct XcdBarrier {
    unsigned* bar; unsigned x;
    volatile LAS unsigned* st;
};

__device__ __forceinline__ XcdBarrier xcd_barrier_post(unsigned* bar, volatile LAS unsigned* st) {
    XcdBarrier b; b.bar = bar; b.x = xb_xcc_id(); b.st = st;
    if (threadIdx.x == 0) (void)xb_add(&bar[XB_XCNT(b.x)], 1u);
    return b;
}
__device__ __forceinline__ void xcd_barrier_complete(unsigned* bar, unsigned x, unsigned& nloc, unsigned& nx) {
    const unsigned G = gridDim.x * gridDim.y * gridDim.z;
    unsigned sum, cnt, mine, sp = 0u;
    for (;;) {
        sum = 0u; cnt = 0u; mine = 0u;
#pragma unroll
        for (unsigned j = 0; j < 16; ++j) { const unsigned c = xb_ld(&bar[XB_XCNT(j)]); sum += c; cnt += (c > 0u) ? 1u : 0u; mine = (j == x) ? c : mine; }
        if (sum == G) break;
        __builtin_amdgcn_s_sleep(1);
        if ((++sp & 255u) == 0u) { if (xb_ld(&bar[XB_TMO])) break; if (sp > XB_SPIN_CAP) { atomicAdd(&bar[XB_TMO], 1u); break; } }
    }
    nloc = mine > 0u ? mine : 1u; nx = cnt > 0u ? cnt : 1u;
}

__device__ __forceinline__ void xcd_barrier(const XcdBarrier& b) {
    asm volatile("s_waitcnt vmcnt(0)" ::: "memory");
    __syncthreads();
    if (threadIdx.x == 0) {
        unsigned* bar = b.bar;
        __builtin_amdgcn_s_waitcnt(0);
        unsigned nloc = b.st[0], nx = b.st[1];
        if (nloc == 0u) { xcd_barrier_complete(bar, b.x, nloc, nx); b.st[0] = nloc; b.st[1] = nx; }
        const unsigned old = xb_add(&bar[XB_XSUB(b.x)], 1u);
        const unsigned gen = old / nloc;
        if (old + 1u == (gen + 1u) * nloc) {
            __builtin_amdgcn_fence(__ATOMIC_RELEASE, "agent");
            asm volatile("s_waitcnt vmcnt(0)" ::: "memory");
            const unsigned og = xb_add(&bar[XB_TOP], 1u);
            const unsigned tg = og / nx;
            if (og + 1u == (tg + 1u) * nx) xb_add(&bar[XB_TOPGEN], 1u);
            else XB_SPIN(xb_ld(&bar[XB_TOPGEN]) == tg, bar);
            __builtin_amdgcn_fence(__ATOMIC_ACQUIRE, "agent");
            xb_add(&bar[XB_XGEN(b.x)], 1u);
            asm volatile("s_waitcnt vmcnt(0)" ::: "memory");
        } else {
            XB_SPIN(xb_ld(&bar[XB_XGEN(b.x)]) == gen, bar);
            __builtin_amdgcn_fence(__ATOMIC_ACQUIRE, "agent");
            asm volatile("s_waitcnt vmcnt(0)" ::: "memory");
        }
    }
    __syncthreads();
}


struct Ctx {
    LAS unsigned char* lds;
    int tid, lane, wave, vcu, G, blk;
    const float* in[21]; float* out; unsigned char* ws;
};
#define WSP(T, off) ((T*)(C.ws + (off)))
#define SMP(T, off) ((T*)(C.ws + WS_SMALL + (off)))

__device__ __forceinline__ void p0_transpose_item(const float* W, int K, int N, bf16* WT, int inter, int up, LAS float* scr, int item, int lane) {
    const int nblk = N / 32, kb = item / nblk, nb = item % nblk, k0 = 64 * kb, n0 = 32 * nb;
    const int drow0 = inter ? ((n0 >> 7) * 256 + (n0 & 127) + (up ? 128 : 0)) : n0;
#pragma unroll 8
    for (int i = 0; i < 32; ++i) { const int kk = 2 * i + (lane >> 5); scr[kk * 33 + (lane & 31)] = W[(size_t)(k0 + kk) * N + n0 + (lane & 31)]; }
    asm volatile("s_waitcnt lgkmcnt(0)" ::: "memory");
    const int c = lane & 7;
#pragma unroll
    for (int j = 0; j < 4; ++j) { const int n = (lane >> 3) + 8 * j; const LAS float* s = scr + (8 * c) * 33 + n;
        v4u o; o.x = pk2(s[0 * 33], s[1 * 33]); o.y = pk2(s[2 * 33], s[3 * 33]); o.z = pk2(s[4 * 33], s[5 * 33]); o.w = pk2(s[6 * 33], s[7 * 33]);
        *(v4u*)(WT + (size_t)(drow0 + n) * K + k0 + 8 * c) = o; }
    asm volatile("s_waitcnt lgkmcnt(0)" ::: "memory");
}
__device__ __forceinline__ float clamp448f(float x) { return __builtin_fminf(__builtin_fmaxf(x, -448.f), 448.f); }
__device__ __forceinline__ unsigned pk4_fp8(float a, float b, float c, float d) { int w = 0; w = __builtin_amdgcn_cvt_pk_fp8_f32(a, b, w, false); w = __builtin_amdgcn_cvt_pk_fp8_f32(c, d, w, true); return (unsigned)w; }
__device__ __forceinline__ void p0_transpose_item_f8(const float* W, int K, int N, unsigned char* WT, int inter, int up, float scale, LAS float* scr, int item, int lane) {
    const int nblk = N / 32, kb = item / nblk, nb = item % nblk, k0 = 64 * kb, n0 = 32 * nb;
    const int drow0 = inter ? ((n0 >> 7) * 256 + (n0 & 127) + (up ? 128 : 0)) : n0;
#pragma unroll 8
    for (int i = 0; i < 32; ++i) { const int kk = 2 * i + (lane >> 5); scr[kk * 33 + (lane & 31)] = W[(size_t)(k0 + kk) * N + n0 + (lane & 31)] * scale; }
    asm volatile("s_waitcnt lgkmcnt(0)" ::: "memory");
    const int n = lane >> 1, hf = lane & 1; const LAS float* s = scr + (32 * hf) * 33 + n;
    v4u o0, o1;
    o0.x = pk4_fp8(s[0 * 33], s[1 * 33], s[2 * 33], s[3 * 33]);     o0.y = pk4_fp8(s[4 * 33], s[5 * 33], s[6 * 33], s[7 * 33]);
    o0.z = pk4_fp8(s[8 * 33], s[9 * 33], s[10 * 33], s[11 * 33]);   o0.w = pk4_fp8(s[12 * 33], s[13 * 33], s[14 * 33], s[15 * 33]);
    o1.x = pk4_fp8(s[16 * 33], s[17 * 33], s[18 * 33], s[19 * 33]); o1.y = pk4_fp8(s[20 * 33], s[21 * 33], s[22 * 33], s[23 * 33]);
    o1.z = pk4_fp8(s[24 * 33], s[25 * 33], s[26 * 33], s[27 * 33]); o1.w = pk4_fp8(s[28 * 33], s[29 * 33], s[30 * 33], s[31 * 33]);
    unsigned char* dst = WT + (size_t)(drow0 + n) * K + k0 + 32 * hf;
    *(v4u*)dst = o0; *(v4u*)(dst + 16) = o1;
    asm volatile("s_waitcnt lgkmcnt(0)" ::: "memory");
}
__device__ __forceinline__ void p0_adaln_item(const Ctx& C, int it) {
    const int layer = it / 96, n0 = (it % 96) * 64;
    const float* W = C.in[4] + (size_t)layer * DMODEL * 6144;
    const float* cvec = C.in[1]; const float* cctx = C.in[3];
    const int cq = C.tid & 15, kp = C.tid >> 4;
    f32x4 a = {0.f, 0.f, 0.f, 0.f}, ac = {0.f, 0.f, 0.f, 0.f};
#pragma unroll 4
    for (int i = 0; i < 32; ++i) { const int k = kp * 32 + i; const float s = silu_f(cvec[k]), sc = silu_f(cctx[k]);
        const f32x4 w = *(const f32x4*)(W + (size_t)k * 6144 + n0 + 4 * cq); a += s * w; ac += sc * w; }
    LAS float* scr = (LAS float*)C.lds;
    *(LAS f32x4*)(scr + kp * 64 + 4 * cq) = a; *(LAS f32x4*)(scr + 2048 + kp * 64 + 4 * cq) = ac;
    __syncthreads();
    if (C.tid < 128) { const int which = C.tid >> 6, col = C.tid & 63; float s = 0.f;
        for (int q = 0; q < 32; ++q) s += scr[which * 2048 + q * 64 + col];
        const int n = n0 + col; const float b = C.in[5][layer * 6144 + n];
        if (which == 0) SMP(float, layer ? SM_MOD1 : SM_MOD0)[n] = s + b;
        else if (layer == 0 && n < 2048) SMP(float, SM_CMOD)[n] = s + b; }
    __syncthreads();
}
__device__ __forceinline__ void p0_prologue(const Ctx& C) {
    for (int it = C.blk; it < 192; it += C.G) p0_adaln_item(C, it);
    LAS float* scr = (LAS float*)(C.lds + C.wave * 16384);
    const int gw = C.vcu * NWAVES + C.wave, NGW = C.G * NWAVES;
    constexpr int I_IN0 = 16 * 48, I_OUT = 16 * 32, I_G0 = 16 * 88, I_D0 = 44 * 32, I_IN1 = 16 * 96, I_EG = 16 * 112, I_ED = 56 * 32;
    constexpr int NITEMS = I_IN0 + I_OUT + 2 * I_G0 + I_D0 + I_IN1 + I_OUT + 8 * (2 * I_EG + I_ED);
    for (int it = gw; it < NITEMS; it += NGW) {
        int r = it;
        if (r < I_IN0) { p0_transpose_item(C.in[7], 1024, 1536, WSP(bf16, WS_WIN0), 0, 0, scr, r, C.lane); continue; } r -= I_IN0;
        if (r < I_OUT) { p0_transpose_item(C.in[10], 1024, 1024, WSP(bf16, WS_WOUT0), 0, 0, scr, r, C.lane); continue; } r -= I_OUT;
        if (r < I_G0) { p0_transpose_item(C.in[11], 1024, DFF, WSP(bf16, WS_WGU0), 1, 0, scr, r, C.lane); continue; } r -= I_G0;
        if (r < I_G0) { p0_transpose_item(C.in[12], 1024, DFF, WSP(bf16, WS_WGU0), 1, 1, scr, r, C.lane); continue; } r -= I_G0;
        if (r < I_D0) { p0_transpose_item(C.in[13], DFF, 1024, WSP(bf16, WS_WDN0), 0, 0, scr, r, C.lane); continue; } r -= I_D0;
        if (r < I_IN1) { p0_transpose_item(C.in[14], 1024, 3072, WSP(bf16, WS_WIN1), 0, 0, scr, r, C.lane); continue; } r -= I_IN1;
        if (r < I_OUT) { p0_transpose_item(C.in[16], 1024, 1024, WSP(bf16, WS_WOUT1), 0, 0, scr, r, C.lane); continue; } r -= I_OUT;
        const int per_e = 2 * I_EG + I_ED, e = r / per_e; r -= e * per_e;
        if (r < I_EG) { p0_transpose_item_f8(C.in[18] + (size_t)e * 1024 * DEXP, 1024, DEXP, WSP(unsigned char, WS_WEGU) + (size_t)e * 2 * DEXP * 1024, 1, 0, WSCALE_GU, scr, r, C.lane); continue; } r -= I_EG;
        if (r < I_EG) { p0_transpose_item_f8(C.in[19] + (size_t)e * 1024 * DEXP, 1024, DEXP, WSP(unsigned char, WS_WEGU) + (size_t)e * 2 * DEXP * 1024, 1, 1, WSCALE_GU, scr, r, C.lane); continue; } r -= I_EG;
        p0_transpose_item_f8(C.in[20] + (size_t)e * DEXP * 1024, DEXP, 1024, WSP(unsigned char, WS_WEDN) + (size_t)e * 1024 * DEXP, 0, 0, WSCALE_DN, scr, r, C.lane);
    }
}

__device__ __forceinline__ void p1_modulate(const Ctx& C) {
    LAS float* V = (LAS float*)C.lds;
    const float* g = C.in[6]; const float* mod = SMP(float, SM_MOD0); const float* cmod = SMP(float, SM_CMOD);
    for (int c = C.tid; c < 1024; c += 512) { V[c] = g[c] * (1.f + mod[1024 + c]); V[1024 + c] = mod[c]; V[2048 + c] = g[c] * (1.f + cmod[1024 + c]); V[3072 + c] = cmod[c]; }
    __syncthreads();
    const int gw = C.vcu * NWAVES + C.wave, NGW = C.G * NWAVES; bf16* H = WSP(bf16, WS_H);
    for (int m = gw; m < MROWS; m += NGW) {
        const float* src = (m < SEQ) ? C.in[0] + (size_t)m * 1024 : C.in[2] + (size_t)(m - SEQ) * 1024;
        const LAS float* VA = V + ((m < SEQ) ? 0 : 2048); const LAS float* VB = VA + 1024;
        f32x4 v[4]; float ss = 0.f;
#pragma unroll
        for (int j = 0; j < 4; ++j) { v[j] = *(const f32x4*)(src + 4 * C.lane + 256 * j); ss += sum4(v[j] * v[j]); }
        const float r = __builtin_amdgcn_rsqf(wave_sum(ss) * (1.f / 1024.f) + NEPS);
#pragma unroll
        for (int j = 0; j < 4; ++j) { const int c = 4 * C.lane + 256 * j; const f32x4 a = *(const LAS f32x4*)(VA + c), b = *(const LAS f32x4*)(VB + c);
            st_bf4(H + (size_t)m * 1024 + c, v[j] * r * a + b); }
    }
    __syncthreads();
}
template <int MODE>
__device__ __forceinline__ void post_rows(const Ctx& C, const float* gt, const float* gpost, const float* gpre, const float* sc, const float* sh,
                                          const float* xsrc, const bf16* ysrc, float* xdst, bf16* hdst) {
    LAS float* V = (LAS float*)C.lds;
    LAS float* RT = V + 3072;
    LAS int* SEL = (LAS int*)(V + 3072 + 8192);
    LAS int* RNK = SEL + 128;
    for (int c = C.tid; c < 1024; c += 512) { V[c] = gt[c] * gpost[c];
        if (MODE != 3) { V[1024 + c] = gpre[c] * (1.f + sc[c]); V[2048 + c] = sh[c]; } }
    if (MODE == 2) { const float* R = C.in[17]; for (int i = C.tid; i < 8192; i += 512) { const int c = i >> 3, e = i & 7; RT[e * 1024 + c] = R[i]; } }
    __syncthreads();
    const int rows_per_blk = SEQ / C.G, rows_per_wave = rows_per_blk / NWAVES;
    for (int i = 0; i < rows_per_wave; ++i) {
        const int rl = C.wave * rows_per_wave + i, m = C.blk * rows_per_blk + rl;
        f32x4 xv[4], yv[4]; float ss = 0.f;
        if (MODE == 3) {
            const int* tp = SMP(int, SM_TOKP) + 2 * m; const float* tw = SMP(float, SM_TOKW) + 2 * m;
            const int p0 = tp[0], p1 = tp[1]; const float w0 = tw[0], w1 = tw[1];
            const bf16* y0 = WSP(bf16, WS_YP) + (size_t)p0 * 1024; const bf16* y1 = WSP(bf16, WS_YP) + (size_t)p1 * 1024;
#pragma unroll
            for (int j = 0; j < 4; ++j) { const int c = 4 * C.lane + 256 * j; yv[j] = w0 * ld_bf4(y0 + c) + w1 * ld_bf4(y1 + c); }
        } else {
#pragma unroll
            for (int j = 0; j < 4; ++j) yv[j] = ld_bf4(ysrc + (size_t)m * 1024 + 4 * C.lane + 256 * j);
        }
#pragma unroll
        for (int j = 0; j < 4; ++j) { xv[j] = *(const f32x4*)(xsrc + (size_t)m * 1024 + 4 * C.lane + 256 * j); ss += sum4(yv[j] * yv[j]); }
        const float ry = __builtin_amdgcn_rsqf(wave_sum(ss) * (1.f / 1024.f) + NEPS);
        float s1 = 0.f;
#pragma unroll
        for (int j = 0; j < 4; ++j) { const int c = 4 * C.lane + 256 * j; xv[j] += *(const LAS f32x4*)(V + c) * (yv[j] * ry); s1 += sum4(xv[j] * xv[j]);
            *(f32x4*)(xdst + (size_t)m * 1024 + c) = xv[j]; }
        if (MODE == 3) continue;
        const float r1 = __builtin_amdgcn_rsqf(wave_sum(s1) * (1.f / 1024.f) + NEPS);
        f32x4 la = {0.f, 0.f, 0.f, 0.f}, lb = {0.f, 0.f, 0.f, 0.f};
#pragma unroll
        for (int j = 0; j < 4; ++j) { const int c = 4 * C.lane + 256 * j;
            const f32x4 h = xv[j] * r1 * *(const LAS f32x4*)(V + 1024 + c) + *(const LAS f32x4*)(V + 2048 + c);
            if (MODE == 2) *(unsigned*)((unsigned char*)hdst + (size_t)m * 1024 + c) = pk4_fp8(clamp448f(h.x), clamp448f(h.y), clamp448f(h.z), clamp448f(h.w));
            else st_bf4(hdst + (size_t)m * 1024 + c, h);
            if (MODE == 2) {
#pragma unroll
                for (int e = 0; e < 4; ++e) { la[e] += sum4(h * *(const LAS f32x4*)(RT + e * 1024 + c)); lb[e] += sum4(h * *(const LAS f32x4*)(RT + (4 + e) * 1024 + c)); }
            }
        }
        if (MODE == 2) {
#pragma unroll
            for (int e = 0; e < 4; ++e) { la[e] = wave_sum(la[e]); lb[e] = wave_sum(lb[e]); }
            int e0 = 0; float l0 = la[0];
#pragma unroll
            for (int e = 1; e < 8; ++e) { const float le = e < 4 ? la[e & 3] : lb[e & 3]; if (le > l0) { l0 = le; e0 = e; } }
            int e1 = -1; float l1 = -INFINITY;
#pragma unroll
            for (int e = 0; e < 8; ++e) { const float le = e < 4 ? la[e & 3] : lb[e & 3]; if (e != e0 && le > l1) { l1 = le; e1 = e; } }
            const float w0 = __builtin_amdgcn_rcpf(1.f + fast_exp(l1 - l0)), w1 = 1.f - w0;
            if (C.lane == 0) { int* te = SMP(int, SM_TOKE) + 2 * m; te[0] = e0; te[1] = e1; float* tw = SMP(float, SM_TOKW) + 2 * m; tw[0] = w0; tw[1] = w1;
                SEL[2 * rl] = e0; SEL[2 * rl + 1] = e1; }
        }
    }
    if (MODE == 2) {
        __syncthreads();
        if (C.tid < 8) { int cnt = 0; for (int q = 0; q < 2 * rows_per_blk; ++q) if (SEL[q] == C.tid) { RNK[q] = cnt; ++cnt; }
            SMP(int, SM_BLKCNT)[C.blk * 8 + C.tid] = cnt; }
        __syncthreads();
        if (C.tid < 2 * rows_per_blk) SMP(int, SM_TOKR)[C.blk * 2 * rows_per_blk + C.tid] = RNK[C.tid];
    }
    __syncthreads();
}

__device__ __forceinline__ void p3_qknorm_rope(const Ctx& C) {
    const int gw = C.vcu * NWAVES + C.wave, NGW = C.G * NWAVES; bf16* QK = WSP(bf16, WS_QKVF);
    const int hd = C.lane >> 2, sub = C.lane & 3; const bool isq = hd < 12;
    const float* gain = isq ? C.in[8] : C.in[9];
    f32x4 g0 = *(const f32x4*)(gain + 4 * sub), g1 = *(const f32x4*)(gain + 16 + 4 * sub), g2 = *(const f32x4*)(gain + 32 + 4 * sub), g3 = *(const f32x4*)(gain + 48 + 4 * sub);
    f32x4 invf;
#pragma unroll
    for (int e = 0; e < 4; ++e) invf[e] = __builtin_amdgcn_exp2f(-(float)(4 * sub + e) * (13.287712379549449f / 16.f));
    const float qs = isq ? (0.125f * 1.4426950408889634f) : 1.f;
    for (int m = gw; m < MROWS; m += NGW) {
        if (m >= SEQ && isq) continue;
        bf16* p = QK + (size_t)m * NQKVF + hd * 64 + 4 * sub;
        f32x4 a0 = ld_bf4(p), a1 = ld_bf4(p + 16), b0 = ld_bf4(p + 32), b1 = ld_bf4(p + 48);
        float ss = sum4(a0 * a0) + sum4(a1 * a1) + sum4(b0 * b0) + sum4(b1 * b1);
        ss += __shfl_xor(ss, 1); ss += __shfl_xor(ss, 2);
        const float r = __builtin_amdgcn_rsqf(ss * (1.f / 64.f) + NEPS) * qs;
        a0 = a0 * r * g0; a1 = a1 * r * g1; b0 = b0 * r * g2; b1 = b1 * r * g3;
        if (m < SEQ) {
            const float rp = (float)(m >> 6), cp = (float)(m & 63);
            f32x4 o0, o1, o2, o3;
#pragma unroll
            for (int e = 0; e < 4; ++e) {
                const float ar = (rp * invf[e]) * 0.15915494309189535f, ac = (cp * invf[e]) * 0.15915494309189535f;
                const float cr = __builtin_amdgcn_cosf(ar), sr = __builtin_amdgcn_sinf(ar), cc = __builtin_amdgcn_cosf(ac), sc = __builtin_amdgcn_sinf(ac);
                o0[e] = a0[e] * cr - a1[e] * sr; o1[e] = a0[e] * sr + a1[e] * cr; o2[e] = b0[e] * cc - b1[e] * sc; o3[e] = b0[e] * sc + b1[e] * cc; }
            a0 = o0; a1 = o1; b0 = o2; b1 = o3;
        }
        st_bf4(p, a0); st_bf4(p + 16, a1); st_bf4(p + 32, b0); st_bf4(p + 48, b1);
    }
}


__device__ __forceinline__ void head_load(const bf16* p, f32x4 (&x)[16]) {
#pragma unroll
    for (int j = 0; j < 8; ++j) { const v4u w = *(const v4u*)(p + 8 * j); x[2 * j] = (f32x4){bflo(w.x), bfhi(w.x), bflo(w.y), bfhi(w.y)}; x[2 * j + 1] = (f32x4){bflo(w.z), bfhi(w.z), bflo(w.w), bfhi(w.w)}; }
}
__device__ __forceinline__ void head_norm_rope(f32x4 (&x)[16], const float* gain, float scale, bool rope, int t) {
    float ss = 0.f;
#pragma unroll
    for (int j = 0; j < 16; ++j) ss += sum4(x[j] * x[j]);
    const float r = __builtin_amdgcn_rsqf(ss * (1.f / 64.f) + NEPS) * scale;
#pragma unroll
    for (int j = 0; j < 16; ++j) x[j] = x[j] * r * *(const f32x4*)(gain + 4 * j);
    if (rope) {
        const float rp = (float)(t >> 6), cp = (float)(t & 63);
#pragma unroll
        for (int j = 0; j < 4; ++j)
#pragma unroll
            for (int e = 0; e < 4; ++e) {
                const float invf = __builtin_amdgcn_exp2f(-(float)(4 * j + e) * (13.287712379549449f / 16.f));
                const float ar = (rp * invf) * 0.15915494309189535f, ac = (cp * invf) * 0.15915494309189535f;
                const float cr = __builtin_amdgcn_cosf(ar), sr = __builtin_amdgcn_sinf(ar), cc = __builtin_amdgcn_cosf(ac), sc = __builtin_amdgcn_sinf(ac);
                const float a0 = x[j][e], a1 = x[j + 4][e], b0 = x[8 + j][e], b1 = x[12 + j][e];
                x[j][e] = a0 * cr - a1 * sr; x[j + 4][e] = a0 * sr + a1 * cr; x[8 + j][e] = b0 * cc - b1 * sc; x[12 + j][e] = b0 * sc + b1 * cc; }
    }
}
__device__ __forceinline__ v4u head_pack(const f32x4 (&x)[16], int c) {
    v4u o;
    o.x = pk4_fp8(clamp448f(x[4 * c][0]), clamp448f(x[4 * c][1]), clamp448f(x[4 * c][2]), clamp448f(x[4 * c][3]));
    o.y = pk4_fp8(clamp448f(x[4 * c + 1][0]), clamp448f(x[4 * c + 1][1]), clamp448f(x[4 * c + 1][2]), clamp448f(x[4 * c + 1][3]));
    o.z = pk4_fp8(clamp448f(x[4 * c + 2][0]), clamp448f(x[4 * c + 2][1]), clamp448f(x[4 * c + 2][2]), clamp448f(x[4 * c + 2][3]));
    o.w = pk4_fp8(clamp448f(x[4 * c + 3][0]), clamp448f(x[4 * c + 3][1]), clamp448f(x[4 * c + 3][2]), clamp448f(x[4 * c + 3][3]));
    return o;
}
__device__ __forceinline__ float fp8_sumsq(v4u w) {
    float s = 0.f;
#pragma unroll
    for (int q = 0; q < 4; ++q) { const float a = __builtin_amdgcn_cvt_f32_fp8((int)w[q], 0), b = __builtin_amdgcn_cvt_f32_fp8((int)w[q], 1), c = __builtin_amdgcn_cvt_f32_fp8((int)w[q], 2), d = __builtin_amdgcn_cvt_f32_fp8((int)w[q], 3);
        s += (a * a + b * b) + (c * c + d * d); }
    return s;
}
__device__ __forceinline__ void p3_attn_operands(const Ctx& C) {
    const int gw = C.vcu * NWAVES + C.wave, NGW = C.G * NWAVES; const bf16* QK = WSP(bf16, WS_QKVF);
    LAS unsigned char* scr = C.lds + C.wave * 4096;
    constexpr int NQI = 256 * 12, NKI = 260 * 4;
#pragma unroll 1
    for (int it = gw; it < NQI; it += NGW) {
        f32x4 x[16];
        {
            const int tile = it / 12, hq = it % 12, t = tile * 64 + C.lane;
            head_load(QK + (size_t)t * NQKVF + hq * 64, x);
            head_norm_rope(x, C.in[8], 0.125f * 1.4426950408889634f, true, t);
            v4u* dst = (v4u*)(WSP(unsigned char, WS_Q8) + ((size_t)hq * SEQ + t) * 64);
            float ss = 0.f;
#pragma unroll
            for (int c = 0; c < 4; ++c) { const v4u pk = head_pack(x, c); dst[c] = pk; ss += fp8_sumsq(pk); }
            WSP(float, WS_QN)[(size_t)hq * SEQ + t] = __builtin_sqrtf(ss);
        }
    }
#pragma unroll 1
    for (int it = gw; it < NKI; it += NGW) {
        f32x4 x[16];
        {
            const int r = it, tile = r >> 2, kvh = r & 3, t = tile * 64 + C.lane;
            head_load(QK + (size_t)t * NQKVF + KCOL + kvh * 64, x);
            head_norm_rope(x, C.in[9], 1.f, tile < 256, t);
            unsigned char* dst = WSP(unsigned char, WS_K8) + (((size_t)kvh * 260 + tile) * 64 + C.lane) * 64; const int sw = (C.lane >> 2) & 3;
            float ss = 0.f;
#pragma unroll
            for (int c = 0; c < 4; ++c) { const v4u pk = head_pack(x, c); *(v4u*)(dst + ((c ^ sw) << 4)) = pk; ss += fp8_sumsq(pk); }
            float kn = __builtin_sqrtf(ss);
#pragma unroll
            for (int o = 1; o < 64; o <<= 1) kn = __builtin_fmaxf(kn, __shfl_xor(kn, o));
            if (C.lane == 0) atomicMax((unsigned*)(C.ws + WS_CTL) + CW_KMAX + 64 * kvh, __float_as_uint(kn));
        }
    }
#pragma unroll 1
    for (int it = gw; it < NKI; it += NGW) {
        f32x4 x[16];
        {
            const int r = it, tile = r >> 2, kvh = r & 3, t = tile * 64 + C.lane;
            head_load(QK + (size_t)t * NQKVF + VCOL + kvh * 64, x);
            const int b = C.lane >> 5, w = C.lane & 31, khi = (w >> 2) & 1, rr = (w & 3) + 4 * (w >> 3), pos = 32 * khi + 16 * b + rr;
#pragma unroll
            for (int c = 0; c < 4; ++c) { const v4u pk = head_pack(x, c);
#pragma unroll
                for (int q = 0; q < 4; ++q)
#pragma unroll
                    for (int e = 0; e < 4; ++e) { const int d = 16 * c + 4 * q + e; scr[d * 64 + ((((pos >> 4) ^ ((d >> 2) & 3))) << 4) + (pos & 15)] = (unsigned char)((pk[q] >> (8 * e)) & 0xffu); } }
            asm volatile("s_waitcnt lgkmcnt(0)" ::: "memory");
            v4u* dst = (v4u*)(WSP(unsigned char, WS_VT8) + (((size_t)kvh * 260 + tile) * 64 + C.lane) * 64);
#pragma unroll
            for (int c = 0; c < 4; ++c) dst[c] = *(const LAS v4u*)(scr + C.lane * 64 + 16 * c);
            asm volatile("s_waitcnt lgkmcnt(0)" ::: "memory");
        }
    }
}

__device__ __forceinline__ void dft128_frags(int wave, int fr, int kg, bf16x8 (&dc)[4], bf16x8 (&ds)[4]) {
#pragma unroll
    for (int ks = 0; ks < 4; ++ks)
#pragma unroll
        for (int i = 0; i < 8; ++i) { const int k = 16 * wave + fr, t = 32 * ks + 8 * kg + i; const float f = (float)((k * t) & 127) * (1.f / 128.f);
            dc[ks][i] = (short)f2bf(__builtin_amdgcn_cosf(f)); ds[ks][i] = (short)f2bf(__builtin_amdgcn_sinf(f)); }
}
__device__ __forceinline__ bf16x8 neg8(bf16x8 v) { v4u u = __builtin_bit_cast(v4u, v); u ^= 0x80008000u; return __builtin_bit_cast(bf16x8, u); }
__device__ __forceinline__ void fourier1_unit(const Ctx& C, int t2, int jh, const bf16x8 (&dc)[4], const bf16x8 (&ds)[4]) {
    LAS bf16* UT = (LAS bf16*)C.lds;
    const bf16* QK = WSP(bf16, WS_QKVF);
#pragma unroll
    for (int i = 0; i < 4; ++i) { const int ch = C.tid + 512 * i, t1 = ch >> 4, c8 = ch & 15;
        const v4u v = *(const v4u*)(QK + (size_t)(128 * t1 + t2) * NQKVF + FCOL + jh * 128 + c8 * 8);
#pragma unroll
        for (int e = 0; e < 4; ++e) { UT[(c8 * 8 + 2 * e) * 136 + t1] = (bf16)(v[e] & 0xffffu); UT[(c8 * 8 + 2 * e + 1) * 136 + t1] = (bf16)(v[e] >> 16); } }
    __syncthreads();
    const int fr = C.lane & 15, kg = C.lane >> 4;
    bf16* PB = WSP(bf16, WS_PB); bf16* QB = WSP(bf16, WS_QB);
#pragma unroll 1
    for (int nh = 0; nh < 2; ++nh) {
        f32x4 aC[4], aS[4];
#pragma unroll
        for (int nt = 0; nt < 4; ++nt) { aC[nt] = (f32x4){0.f, 0.f, 0.f, 0.f}; aS[nt] = (f32x4){0.f, 0.f, 0.f, 0.f}; }
#pragma unroll
        for (int ks = 0; ks < 4; ++ks)
#pragma unroll
            for (int nt = 0; nt < 4; ++nt) { const bf16x8 b = *(const LAS bf16x8*)(UT + (64 * nh + 16 * nt + fr) * 136 + 32 * ks + 8 * kg);
                aC[nt] = __builtin_amdgcn_mfma_f32_16x16x32_bf16(dc[ks], b, aC[nt], 0, 0, 0); aS[nt] = __builtin_amdgcn_mfma_f32_16x16x32_bf16(ds[ks], b, aS[nt], 0, 0, 0); }
#pragma unroll
        for (int rg = 0; rg < 4; ++rg) { const int k1 = 16 * C.wave + 4 * kg + rg; const float ph = (float)(k1 * t2) * (1.f / 16384.f);
            const float cp = __builtin_amdgcn_cosf(ph), sp = __builtin_amdgcn_sinf(ph); const size_t ro = ((size_t)k1 * 128 + t2) * 256 + jh * 128 + nh * 64 + fr;
#pragma unroll
            for (int nt = 0; nt < 4; ++nt) { const float sr = aC[nt][rg], ss = aS[nt][rg];
                PB[ro + 16 * nt] = (bf16)f2bf(sr * cp - ss * sp); QB[ro + 16 * nt] = (bf16)f2bf(sr * sp + ss * cp); } }
    }
    __syncthreads();
}
constexpr int F2_CT_OFF = 40960, F2_ST_OFF = 40960 + 9216;
__device__ __forceinline__ void fourier2_tables(const Ctx& C) {
    LAS bf16* CT = (LAS bf16*)(C.lds + F2_CT_OFF); LAS bf16* ST = (LAS bf16*)(C.lds + F2_ST_OFF);
    for (int i = C.tid; i < 4096; i += 512) { const int m = i >> 6, j = i & 63; const float f = (float)((m * j) & 63) * (1.f / 64.f);
        CT[m * 72 + j] = (bf16)f2bf(__builtin_amdgcn_cosf(f)); ST[m * 72 + j] = (bf16)f2bf(__builtin_amdgcn_sinf(f)); }
    __syncthreads();
}
__device__ __forceinline__ void fourier2_unit(const Ctx& C, int k1, int g, const bf16x8 (&dc)[4], const bf16x8 (&ds)[4]) {
    LAS bf16* PT = (LAS bf16*)C.lds; LAS bf16* QT = PT + 64 * 136;
    LAS bf16* XR = (LAS bf16*)C.lds; LAS bf16* XQ = XR + 128 * 72;
    const LAS bf16* CT = (const LAS bf16*)(C.lds + F2_CT_OFF); const LAS bf16* ST = (const LAS bf16*)(C.lds + F2_ST_OFF);
    const bf16* PB = WSP(bf16, WS_PB); const bf16* QB = WSP(bf16, WS_QB);
#pragma unroll
    for (int i = 0; i < 4; ++i) { const int ch = C.tid + 512 * i, mat = ch >> 10, r = ch & 1023, t2 = r >> 3, c8 = r & 7;
        const v4u v = *(const v4u*)((mat ? QB : PB) + ((size_t)k1 * 128 + t2) * 256 + g * 64 + c8 * 8); LAS bf16* dst = mat ? QT : PT;
#pragma unroll
        for (int e = 0; e < 4; ++e) { dst[(c8 * 8 + 2 * e) * 136 + t2] = (bf16)(v[e] & 0xffffu); dst[(c8 * 8 + 2 * e + 1) * 136 + t2] = (bf16)(v[e] >> 16); } }
    __syncthreads();
    const int fr = C.lane & 15, kg = C.lane >> 4;
    f32x4 xr[4], xq[4];
#pragma unroll
    for (int nt = 0; nt < 4; ++nt) { xr[nt] = (f32x4){0.f, 0.f, 0.f, 0.f}; xq[nt] = (f32x4){0.f, 0.f, 0.f, 0.f}; }
#pragma unroll
    for (int ks = 0; ks < 4; ++ks)
#pragma unroll
        for (int nt = 0; nt < 4; ++nt) { const bf16x8 bp = *(const LAS bf16x8*)(PT + (16 * nt + fr) * 136 + 32 * ks + 8 * kg), bq = *(const LAS bf16x8*)(QT + (16 * nt + fr) * 136 + 32 * ks + 8 * kg);
            xr[nt] = __builtin_amdgcn_mfma_f32_16x16x32_bf16(dc[ks], bp, xr[nt], 0, 0, 0); xr[nt] = __builtin_amdgcn_mfma_f32_16x16x32_bf16(ds[ks], neg8(bq), xr[nt], 0, 0, 0);
            xq[nt] = __builtin_amdgcn_mfma_f32_16x16x32_bf16(dc[ks], bq, xq[nt], 0, 0, 0); xq[nt] = __builtin_amdgcn_mfma_f32_16x16x32_bf16(ds[ks], bp, xq[nt], 0, 0, 0); }
    __syncthreads();
#pragma unroll
    for (int nt = 0; nt < 4; ++nt)
#pragma unroll
        for (int rg = 0; rg < 4; ++rg) { const int k2 = 16 * C.wave + 4 * kg + rg, j = 16 * nt + fr; XR[k2 * 72 + j] = (bf16)f2bf(xr[nt][rg]); XQ[k2 * 72 + j] = (bf16)f2bf(xq[nt][rg]); }
    __syncthreads();
    f32x4 o[4];
#pragma unroll
    for (int nt = 0; nt < 4; ++nt) o[nt] = (f32x4){0.f, 0.f, 0.f, 0.f};
#pragma unroll
    for (int ks = 0; ks < 2; ++ks) { const bf16x8 ar = *(const LAS bf16x8*)(XR + (16 * C.wave + fr) * 72 + 32 * ks + 8 * kg), aq = neg8(*(const LAS bf16x8*)(XQ + (16 * C.wave + fr) * 72 + 32 * ks + 8 * kg));
#pragma unroll
        for (int nt = 0; nt < 4; ++nt) { const bf16x8 bc = *(const LAS bf16x8*)(CT + (16 * nt + fr) * 72 + 32 * ks + 8 * kg), bs = *(const LAS bf16x8*)(ST + (16 * nt + fr) * 72 + 32 * ks + 8 * kg);
            o[nt] = __builtin_amdgcn_mfma_f32_16x16x32_bf16(ar, bc, o[nt], 0, 0, 0); o[nt] = __builtin_amdgcn_mfma_f32_16x16x32_bf16(aq, bs, o[nt], 0, 0, 0); } }
    bf16* MIX = WSP(bf16, WS_MIX);
#pragma unroll
    for (int nt = 0; nt < 4; ++nt)
#pragma unroll
        for (int rg = 0; rg < 4; ++rg) { const int k2 = 16 * C.wave + 4 * kg + rg; MIX[(size_t)(k1 + 128 * k2) * 1024 + 768 + 64 * g + 16 * nt + fr] = (bf16)f2bf(o[nt][rg] * (1.f / 1024.f)); }
    __syncthreads();
}

__device__ __forceinline__ void p11_conv_gate(const Ctx& C) {
    const bf16* B = WSP(bf16, WS_BCU); bf16* V = WSP(bf16, WS_VB); const float* cw = C.in[15];
    const int nthr = C.G * 512;
    for (int idx = C.blk * 512 + C.tid; idx < SEQ * 128; idx += nthr) {
        const int t = idx >> 7, c0 = (idx & 127) * 8;
        const bf16* row = B + (size_t)t * 3072 + c0;
        float cu[3][8];
#pragma unroll
        for (int d = 0; d < 3; ++d) { const int tt = t + d - 1; const bool ok = (tt >= 0) && (tt < SEQ);
            f32x4 c_lo = {0.f, 0.f, 0.f, 0.f}, c_hi = c_lo, u_lo = c_lo, u_hi = c_lo;
            if (ok) { const bf16* r2 = B + (size_t)tt * 3072 + c0; c_lo = ld_bf4(r2 + 1024); c_hi = ld_bf4(r2 + 1028); u_lo = ld_bf4(r2 + 2048); u_hi = ld_bf4(r2 + 2052); }
#pragma unroll
            for (int e = 0; e < 4; ++e) { cu[d][e] = c_lo[e] * u_lo[e]; cu[d][4 + e] = c_hi[e] * u_hi[e]; } }
        const f32x4 b_lo = ld_bf4(row), b_hi = ld_bf4(row + 4);
        f32x4 o_lo, o_hi;
#pragma unroll
        for (int e = 0; e < 4; ++e) {
            o_lo[e] = b_lo[e] * (cw[c0 + e] * cu[0][e] + cw[1024 + c0 + e] * cu[1][e] + cw[2048 + c0 + e] * cu[2][e]);
            o_hi[e] = b_hi[e] * (cw[c0 + 4 + e] * cu[0][4 + e] + cw[1024 + c0 + 4 + e] * cu[1][4 + e] + cw[2048 + c0 + 4 + e] * cu[2][4 + e]); }
        st_bf4(V + (size_t)t * 1024 + c0, o_lo); st_bf4(V + (size_t)t * 1024 + c0 + 4, o_hi);
    }
}

__device__ __forceinline__ void p14_gather(const Ctx& C) {
    LAS unsigned* T = (LAS unsigned*)C.lds;
    if (C.tid < 24) T[C.tid] = 0u;
    __syncthreads();
    const int* bc = SMP(int, SM_BLKCNT);
    for (int idx = C.tid; idx < C.G * 8; idx += 512) { const int b = idx >> 3, e = idx & 7; const unsigned v = (unsigned)bc[idx];
        atomicAdd((unsigned*)&T[e], v); if (b < C.blk) atomicAdd((unsigned*)&T[8 + e], v); }
    __syncthreads();
    if (C.tid == 0) { unsigned off = 0, tile = 0; int* te = SMP(int, SM_TILEE);
        for (int e = 0; e < 8; ++e) { T[16 + e] = off + T[8 + e]; const unsigned nt = (T[e] + 255u) >> 8;
            if (C.blk == 0) for (unsigned q = 0; q < nt; ++q) te[tile + q] = e;
            tile += nt; off += nt * 256u; }
        if (C.blk == 0) te[MOE_TILES_MAX] = (int)tile; }
    __syncthreads();
    const int rows_per_blk = SEQ / C.G, ent_per_wave = 2 * rows_per_blk / NWAVES;
    const unsigned char* H = WSP(unsigned char, WS_H2); unsigned char* HP = WSP(unsigned char, WS_HPERM);
    for (int i = 0; i < ent_per_wave; ++i) { const int ent = C.wave * ent_per_wave + i, gent = C.blk * 2 * rows_per_blk + ent, m = gent >> 1;
        const int e = SMP(int, SM_TOKE)[gent], rk = SMP(int, SM_TOKR)[gent]; const int pos = (int)T[16 + e] + rk;
        const v4u* src = (const v4u*)(H + (size_t)m * 1024); v4u* dst = (v4u*)(HP + (size_t)pos * 1024);
        dst[C.lane] = src[C.lane];
        if (C.lane == 0) SMP(int, SM_TOKP)[gent] = pos; }
    __syncthreads();
}

struct MoeOrder {
    pg8::StaticOrder so; int t0, bstride, a_rel; const LAS int* te;
    __device__ __forceinline__ void init(int t0_, int ntiles, int nN, int bstride_, int a_rel_, const LAS int* te_, int G, int c) {
        t0 = t0_; bstride = bstride_; a_rel = a_rel_; te = te_; so.nM = ntiles; so.nN = nN; so.nwg = ntiles * nN; so.G = G; so.c = c; }
    __device__ __forceinline__ bool next(int i, pg8::Unit& u) const {
        if (!so.next(i, u)) return false;
        const int loc = u.pm, tile = t0 + loc, e = __builtin_amdgcn_readfirstlane(te[tile]);
        u.pb = e * bstride + u.pn;
        if (a_rel) { u.pa = loc; u.pm = tile; } else { u.pa = tile; u.pm = loc; }
        return true; }
    __device__ __forceinline__ void a_ready(const pg8::Unit&) const {}
    __device__ __forceinline__ void done(const pg8::Unit&) const {}
};

struct Args { const float* in[21]; float* out; unsigned char* ws; int ph_lo, ph_hi; };
__global__ void __launch_bounds__(NWAVES * 64, 2) mk_fwd(Args args) {
    extern __shared__ __attribute__((aligned(16))) unsigned char lds[];
    Ctx C;
    C.lds = (LAS unsigned char*)lds;
    C.tid = threadIdx.x; C.lane = C.tid & 63; C.wave = __builtin_amdgcn_readfirstlane(C.tid >> 6);
    C.G = gridDim.x; C.blk = blockIdx.x; C.vcu = (C.G % 8 == 0) ? (C.blk % 8) * (C.G / 8) + C.blk / 8 : C.blk;
#pragma unroll
    for (int i = 0; i < 21; ++i) C.in[i] = args.in[i];
    C.out = args.out; C.ws = args.ws;
    volatile LAS unsigned* LCTL = (volatile LAS unsigned*)(C.lds + LDSCTL_OFF);
    for (int u = C.tid; u < (LDS_BYTES - LDSCTL_OFF) / 4; u += NWAVES * 64) LCTL[u] = 0u;
    __syncthreads();
    const int lo = args.ph_lo, hi = args.ph_hi;
    const bool use_bar = (hi - lo) > 1;
    XcdBarrier bar; bar.bar = (unsigned*)(C.ws + WS_CTL) + CW_BAR; bar.x = 0; bar.st = LCTL;
    if (use_bar) bar = xcd_barrier_post((unsigned*)(C.ws + WS_CTL) + CW_BAR, LCTL);
#define IN(k) (lo <= (k) && (k) < hi)
#define SEAM(k) do { if (IN(k) && IN((k) + 1)) xcd_barrier(bar); } while (0)
    const float* mod0 = SMP(float, SM_MOD0); const float* mod1 = SMP(float, SM_MOD1); const float* nw = C.in[6];
    LAS unsigned char* ring = C.lds + RING_OFF;

#ifndef ATTN_CHECK
#define ATTN_CHECK 0
#endif
#ifndef ATTN_TOL
#define ATTN_TOL 0.01f
#endif
#ifndef REP_P0
#define REP_P0 1
#endif
#ifndef REP_ATT
#define REP_ATT 1
#endif
#ifndef REP_MOE
#define REP_MOE 1
#endif
#ifndef REP_THIN
#define REP_THIN 1
#endif
#ifndef REP_GEMM
#define REP_GEMM 1
#endif
    if (IN(0)) { for (int rp = 0; rp < REP_P0; ++rp) { p0_prologue(C); __syncthreads(); } } SEAM(0);
    if (IN(1)) { for (int rp = 0; rp < REP_THIN; ++rp) p1_modulate(C); } SEAM(1);
    if (IN(2)) {
        pg8::Gemm g{WSP(bf16, WS_H), WSP(bf16, WS_WIN0), MROWS, NQKVF, 1024}; pg8::StaticOrder S; S.init(MROWS, NQKVF, C.G, C.blk);
        pg8::EpiBf16<0> E{WSP(bf16, WS_QKVF), NQKVF, nullptr, 0, 0, 1.f};
        for (int rp = 0; rp < REP_GEMM; ++rp) pg8::gemm_phase<pg8::EpiBf16<0>, pg8::StaticOrder, true, true>(ring, g, S, E);
    } SEAM(2);
    if (IN(3)) {
#if ATTN_CHECK
        p3_attn_operands(C); xcd_barrier(bar);
        p3_qknorm_rope(C);
#else
        p3_attn_operands(C);
        __syncthreads();
#endif
        bf16x8 dc[4], ds[4]; dft128_frags(C.wave, C.lane & 15, C.lane >> 4, dc, ds);
        for (int u = C.vcu; u < 256; u += C.G) fourier1_unit(C, u >> 1, u & 1, dc, ds);
    } SEAM(3);
    if (IN(4)) {
        { bf16x8 dc[4], ds[4]; dft128_frags(C.wave, C.lane & 15, C.lane >> 4, dc, ds);
          fourier2_tables(C);
          for (int u = C.vcu; u < 512; u += C.G) fourier2_unit(C, u >> 2, u & 3, dc, ds); }
        __syncthreads();
#if ATTN_CHECK
        { const attn_body::AttnTensors AT{(const attn_body::bf16*)WSP(bf16, WS_QKVF), (const attn_body::bf16*)(WSP(bf16, WS_QKVF) + KCOL), (const attn_body::bf16*)(WSP(bf16, WS_QKVF) + VCOL), (attn_body::bf16*)WSP(bf16, WS_MIX2)};
          const attn_body::GqaOrder S(C.G, C.blk);
          attn_body::attn_phase<attn_body::GqaOrder>((char*)lds + RING_OFF, AT, S); }
#endif
        { const attn8::Tensors T8{WSP(unsigned char, WS_Q8), WSP(unsigned char, WS_K8), WSP(unsigned char, WS_VT8), WSP(float, WS_QN), (const unsigned*)(C.ws + WS_CTL) + CW_KMAX, (attn8::bf16*)WSP(bf16, WS_MIX)};
          for (int rp = 0; rp < REP_ATT; ++rp) attn8::attn_phase<8>((char*)lds + RING_OFF, T8, C.G, C.blk); }
#if ATTN_CHECK
        xcd_barrier(bar);
        {
            float sd = 0.f, sa = 0.f; const bf16* A = WSP(bf16, WS_MIX2); const bf16* B = WSP(bf16, WS_MIX);
            for (int idx = C.blk * 512 + C.tid; idx < SEQ * 192; idx += C.G * 512) { const int m = idx / 192, c = (idx % 192) * 4; const f32x4 a = ld_bf4(A + (size_t)m * 1024 + c), b = ld_bf4(B + (size_t)m * 1024 + c);
                const f32x4 d = a - b; sd += sum4(d * d); sa += sum4(a * a); }
            sd = wave_sum(sd); sa = wave_sum(sa);
            if (C.lane == 0) { atomicAdd((float*)(C.ws + WS_CTL) + 8000, sd); atomicAdd((float*)(C.ws + WS_CTL) + 8064, sa); }
        }
#endif
    } SEAM(4);
    if (IN(5)) {
        pg8::Gemm g{WSP(bf16, WS_MIX), WSP(bf16, WS_WOUT0), SEQ, 1024, 1024}; pg8::StaticOrder S; S.init(SEQ, 1024, C.G, C.blk);
        pg8::EpiBf16<0> E{WSP(bf16, WS_Y), 1024, nullptr, 0, 0, 1.f};
        for (int rp = 0; rp < REP_GEMM; ++rp) pg8::gemm_phase<pg8::EpiBf16<0>, pg8::StaticOrder, true, true>(ring, g, S, E);
    } SEAM(5);
    if (IN(6)) { for (int rp = 0; rp < REP_THIN; ++rp) post_rows<1>(C, mod0 + 2048, nw + 1024, nw + 2048, mod0 + 4096, mod0 + 3072, C.in[0], WSP(bf16, WS_Y), C.out, WSP(bf16, WS_H)); } SEAM(6);
    if (IN(7)) {
        pg8::Gemm g{WSP(bf16, WS_H), WSP(bf16, WS_WGU0), SEQ, 2 * DFF, 1024}; pg8::StaticOrder S; S.init(SEQ, 2 * DFF, C.G, C.blk);
        pg8::EpiSwiGLU E{WSP(bf16, WS_ACT0), DFF};
        for (int rp = 0; rp < REP_GEMM; ++rp) pg8::gemm_phase<pg8::EpiSwiGLU, pg8::StaticOrder, true, true>(ring, g, S, E);
    } SEAM(7);
    if (IN(8)) {
        pg8::Gemm g{WSP(bf16, WS_ACT0), WSP(bf16, WS_WDN0), SEQ, 1024, DFF}; pg8::StaticOrder S; S.init(SEQ, 1024, C.G, C.blk);
        pg8::EpiBf16<0> E{WSP(bf16, WS_Y), 1024, nullptr, 0, 0, 1.f};
        for (int rp = 0; rp < REP_GEMM; ++rp) pg8::gemm_phase<pg8::EpiBf16<0>, pg8::StaticOrder, true, true>(ring, g, S, E);
    } SEAM(8);
    if (IN(9)) { post_rows<1>(C, mod0 + 5120, nw + 3072, nw + 4096, mod1 + 1024, mod1, C.out, WSP(bf16, WS_Y), C.out, WSP(bf16, WS_H)); } SEAM(9);
    if (IN(10)) {
        pg8::Gemm g{WSP(bf16, WS_H), WSP(bf16, WS_WIN1), SEQ, 3072, 1024}; pg8::StaticOrder S; S.init(SEQ, 3072, C.G, C.blk);
        pg8::EpiBf16<0> E{WSP(bf16, WS_BCU), 3072, nullptr, 0, 0, 1.f};
        for (int rp = 0; rp < REP_GEMM; ++rp) pg8::gemm_phase<pg8::EpiBf16<0>, pg8::StaticOrder, true, true>(ring, g, S, E);
    } SEAM(10);
    if (IN(11)) { for (int rp = 0; rp < REP_THIN; ++rp) p11_conv_gate(C); } SEAM(11);
    if (IN(12)) {
        pg8::Gemm g{WSP(bf16, WS_VB), WSP(bf16, WS_WOUT1), SEQ, 1024, 1024}; pg8::StaticOrder S; S.init(SEQ, 1024, C.G, C.blk);
        pg8::EpiBf16<0> E{WSP(bf16, WS_Y), 1024, nullptr, 0, 0, 1.f};
        for (int rp = 0; rp < REP_GEMM; ++rp) pg8::gemm_phase<pg8::EpiBf16<0>, pg8::StaticOrder, true, true>(ring, g, S, E);
    } SEAM(12);
    if (IN(13)) { post_rows<2>(C, mod1 + 2048, nw + 4096 + 1024, nw + 4096 + 2048, mod1 + 4096, mod1 + 3072, C.out, WSP(bf16, WS_Y), C.out, WSP(bf16, WS_H2)); } SEAM(13);
    if (IN(14)) { for (int rp = 0; rp < REP_THIN; ++rp) p14_gather(C); } SEAM(14);
    if (IN(15)) {
        LAS int* te = (LAS int*)(C.lds + LDSCTL_OFF + 64); const int* teg = SMP(int, SM_TILEE);
        for (int i = C.tid; i <= MOE_TILES_MAX; i += 512) te[i] = teg[i];
        __syncthreads();
        int np = __builtin_amdgcn_readfirstlane(te[MOE_TILES_MAX]); np = np < 0 ? 0 : (np > MOE_TILES_MAX ? MOE_TILES_MAX : np);
        pg8::Gemm g{WSP(bf16, WS_HPERM), WSP(bf16, WS_WEGU), 0, 2 * DEXP, 1024 / 2}; MoeOrder S;     S.init(0, np, 2 * DEXP / 256, 2 * DEXP / 256, 0, te, C.G, C.blk);
        pg8::EpiSwiGLU8 E{WSP(unsigned char, WS_ACT1), DEXP, 1.f / WSCALE_GU};
        pg8::gemm_phase<pg8::EpiSwiGLU8, MoeOrder, true, true, true>(ring, g, S, E);
    } SEAM(15);
    if (IN(16)) {
        LAS int* te = (LAS int*)(C.lds + LDSCTL_OFF + 64); const int* teg = SMP(int, SM_TILEE);
        for (int i = C.tid; i <= MOE_TILES_MAX; i += 512) te[i] = teg[i];
        __syncthreads();
        int np = __builtin_amdgcn_readfirstlane(te[MOE_TILES_MAX]); np = np < 0 ? 0 : (np > MOE_TILES_MAX ? MOE_TILES_MAX : np);
        pg8::Gemm g{WSP(bf16, WS_ACT1), WSP(bf16, WS_WEDN), 0, 1024, DEXP / 2}; MoeOrder S; S.init(0, np, 4, 4, 1, te, C.G, C.blk);
        pg8::EpiBf16<0> E{WSP(bf16, WS_YP), 1024, nullptr, 1024, 0, 1.f / WSCALE_DN};
        pg8::gemm_phase<pg8::EpiBf16<0>, MoeOrder, true, true, true>(ring, g, S, E);
    } SEAM(16);
    if (IN(17)) {
#if ATTN_CHECK
        { const float sd = __hip_atomic_load((float*)(C.ws + WS_CTL) + 8000, __ATOMIC_RELAXED, __HIP_MEMORY_SCOPE_AGENT), sa = __hip_atomic_load((float*)(C.ws + WS_CTL) + 8064, __ATOMIC_RELAXED, __HIP_MEMORY_SCOPE_AGENT);
          if (!(sd <= (ATTN_TOL) * (ATTN_TOL) * sa) || !(sa > 0.f)) { const float qn = __builtin_nanf(""); for (int idx = C.blk * 512 + C.tid; idx < SEQ * 256; idx += C.G * 512) *(f32x4*)(C.out + (size_t)idx * 4) = (f32x4){qn, qn, qn, qn}; return; } }
#endif
        post_rows<3>(C, mod1 + 5120, nw + 4096 + 3072, nw, mod1, mod1, C.out, nullptr, C.out, nullptr);
    }
#undef IN
#undef SEAM
}

extern "C" void kernel_launch(void* const* d_in, const int* in_sizes, int n_in, void* d_out, int out_size, void* d_ws, size_t ws_size, hipStream_t stream) {
    static int grid = 0;
    if (grid == 0) {
        if (n_in != 21 || in_sizes[0] != SEQ * DMODEL || out_size != SEQ * DMODEL || ws_size < WS_END) {
            fprintf(stderr, "kernel_launch: unexpected problem (n_in %d, in0 %d, out %d, ws %zu, need %zu); nothing launched\n", n_in, n_in > 0 ? in_sizes[0] : -1, out_size, ws_size, (size_t)WS_END); grid = -1; return; }
        int dev = 0, cus = 0;
        if (hipGetDevice(&dev) != hipSuccess || hipDeviceGetAttribute(&cus, hipDeviceAttributeMultiprocessorCount, dev) != hipSuccess) { grid = -1; return; }
        if (hipFuncSetAttribute((const void*)mk_fwd, hipFuncAttributeMaxDynamicSharedMemorySize, LDS_BYTES) != hipSuccess) { fprintf(stderr, "kernel_launch: hipFuncSetAttribute failed\n"); grid = -1; return; }
        int per_cu = 0;
        if (hipOccupancyMaxActiveBlocksPerMultiprocessor(&per_cu, (const void*)mk_fwd, NWAVES * 64, LDS_BYTES) != hipSuccess || per_cu < 1) fprintf(stderr, "kernel_launch: occupancy query reports %d\n", per_cu);
        (void)hipGetLastError();
        if (cus != 256) { fprintf(stderr, "kernel_launch: built for 256 CUs, device has %d; nothing launched\n", cus); grid = -1; return; }
        grid = cus;
    }
    if (grid < 0) return;
    if (hipMemsetAsync((char*)d_ws + WS_CTL, 0, CTL_ZERO_BYTES, stream) != hipSuccess) return;
    Args a{};
    for (int i = 0; i < 21; ++i) a.in[i] = (const float*)d_in[i];
    a.out = (float*)d_out; a.ws = (unsigned char*)d_ws;
#if MK_N_LAUNCHES == 1
    a.ph_lo = 0; a.ph_hi = NPH;
    hipLaunchKernelGGL(mk_fwd, dim3(grid), dim3(NWAVES * 64), LDS_BYTES, stream, a);
#else
    for (int li = 0; li < NPH; ++li) { a.ph_lo = li; a.ph_hi = li + 1; hipLaunchKernelGGL(mk_fwd, dim3(grid), dim3(NWAVES * 64), LDS_BYTES, stream, a); }
#endif
}
```
